# Optimizing an MI355X kernel written in HIP

```python
import math, functools
import jax
import jax.numpy as jnp
from jax import lax
import numpy as np

D_MODEL = 2048
BATCH = 4
SEQ = 4096
DEPTH = 2

GRID_W = 64
CTX_LEN = 256
N_GROUPS = 4
MIX_W = D_MODEL
GROUP_W = MIX_W // N_GROUPS
N_HEADS = 4
HEAD_DIM = GROUP_W // N_HEADS
KV_HEADS = N_HEADS // 2
CHUNK = 64
Q_BLOCK = 128
CONV_K = 5
ROPE_BASE = 10000.0
NORM_EPS = 1e-6
F32 = jnp.float32

IN_LAYOUT = (
    ('m_q', GROUP_W), ('m_k', GROUP_W), ('m_v', GROUP_W), ('m_o', GROUP_W), ('m_z', GROUP_W),
    ('m_i', 2 * N_HEADS), ('m_f', 2 * N_HEADS),
    ('r_q', GROUP_W), ('r_k', GROUP_W), ('r_v', GROUP_W), ('r_z', GROUP_W),
    ('a_q', GROUP_W), ('a_k', KV_HEADS * HEAD_DIM), ('a_v', KV_HEADS * HEAD_DIM), ('a_z', GROUP_W),
    ('d_qkv', 3 * GROUP_W), ('d_z', GROUP_W), ('d_a', 2 * N_HEADS), ('d_b', 2 * N_HEADS),
)
IN_W = sum(size for _, size in IN_LAYOUT)

kernel_name = 'hybrid_mlstm_retention_gqa_deltanet_dit'


def _rms_norm(x, w):
    xf = x.astype(F32)
    y = xf * lax.rsqrt(jnp.mean(xf * xf, axis=-1, keepdims=True) + NORM_EPS)
    return (y * w.astype(F32)).astype(x.dtype)


def _l2_norm(t):
    tf = t.astype(F32)
    return (tf * lax.rsqrt(jnp.sum(tf * tf, axis=-1, keepdims=True) + NORM_EPS)).astype(t.dtype)


def _head_rms(y, w):
    b, n, _ = y.shape
    yf = y.astype(F32).reshape(b, n, -1, HEAD_DIM)
    yf = yf * lax.rsqrt(jnp.mean(yf * yf, axis=-1, keepdims=True) + NORM_EPS)
    return (yf.reshape(b, n, -1) * w.astype(F32)).astype(y.dtype)


def _heads(t):
    b, n, _ = t.shape
    return t.reshape(b, n, -1, HEAD_DIM).transpose(0, 2, 1, 3)


def _unheads(t):
    b, h, n, dh = t.shape
    return t.transpose(0, 2, 1, 3).reshape(b, n, h * dh)


def _gate_heads(t):
    return jnp.swapaxes(t, 1, 2).astype(F32)


def _split_cols(u):
    parts, start = {}, 0
    for name, size in IN_LAYOUT:
        parts[name] = u[..., start:start + size]
        start += size
    return parts


def _axial_rope_tables(rows):
    row = jnp.repeat(jnp.arange(rows), GRID_W)
    col = jnp.tile(jnp.arange(GRID_W), rows)
    n_freq = HEAD_DIM // 4
    inv_freq = ROPE_BASE ** (-jnp.arange(n_freq, dtype=F32) / n_freq)
    ang = jnp.stack([row[:, None] * inv_freq, col[:, None] * inv_freq], axis=1)
    return jnp.cos(ang), jnp.sin(ang)


def _apply_rope(t, cos, sin):
    b, h, n, dh = t.shape
    tr = t.astype(F32).reshape(b, h, n, 2, 2, dh // 4)
    t1, t2 = tr[..., 0, :], tr[..., 1, :]
    out = jnp.stack([t1 * cos - t2 * sin, t2 * cos + t1 * sin], axis=-2)
    return out.reshape(b, h, n, dh).astype(t.dtype)


def _centred_dwconv(t, w):
    pad = CONV_K // 2
    n = t.shape[1]
    tp = jnp.pad(t, ((0, 0), (pad, pad), (0, 0)))
    out = tp[:, 0:n] * w[0]
    for j in range(1, CONV_K):
        out = out + tp[:, j:j + n] * w[j]
    return out


def _to_chunks(t):
    b, h, n = t.shape[:3]
    return t.astype(F32).reshape(b, h, n // CHUNK, CHUNK, *t.shape[3:])


def _scan_major(t):
    return jnp.moveaxis(t, 2, 0)


def _from_chunks(oc):
    nc, b, h, cl, d = oc.shape
    return jnp.moveaxis(oc, 0, 2).reshape(b, h, nc * cl, d)


def _mlstm_scan(q, k, v, log_i, log_f, state):
    tril = jnp.tril(jnp.ones((CHUNK, CHUNK), dtype=bool))
    xs = tuple(_scan_major(_to_chunks(t)) for t in (q, k, v, log_i, log_f))

    def step(carry, inp):
        c_mat, n_vec, m = carry
        qj, kj, vj, li, lf = inp
        b_cum = jnp.cumsum(lf, axis=-1)
        d_mat = jnp.where(tril, b_cum[..., :, None] - b_cum[..., None, :] + li[..., None, :], -jnp.inf)
        inter = m[..., None] + b_cum
        m_t = jnp.maximum(inter, jnp.max(d_mat, axis=-1))
        w_inter = jnp.exp(inter - m_t)
        s = jnp.einsum('bhtd,bhsd->bhts', qj, kj) * jnp.exp(d_mat - m_t[..., None])
        num = w_inter[..., None] * jnp.einsum('bhtd,bhde->bhte', qj, c_mat) + jnp.einsum('bhts,bhse->bhte', s, vj)
        den = w_inter * jnp.einsum('bhtd,bhd->bht', qj, n_vec) + jnp.sum(s, axis=-1)
        h_out = num / jnp.maximum(jnp.abs(den), jnp.exp(-m_t))[..., None]
        b_end = b_cum[..., -1]
        dec = b_end[..., None] - b_cum + li
        m_new = jnp.maximum(m + b_end, jnp.max(dec, axis=-1))
        w_state = jnp.exp(dec - m_new[..., None])
        carry_decay = jnp.exp(m + b_end - m_new)
        c_new = carry_decay[..., None, None] * c_mat + jnp.einsum('bhs,bhsd,bhse->bhde', w_state, kj, vj)
        n_new = carry_decay[..., None] * n_vec + jnp.einsum('bhs,bhsd->bhd', w_state, kj)
        return (c_new, n_new, m_new), h_out

    state, hc = lax.scan(step, state, xs)
    return _from_chunks(hc), state


def _retention_scan(q, k, v, state, log_gamma):
    lg = log_gamma.astype(F32)[:, None]
    idx = jnp.arange(CHUNK, dtype=F32)
    rel = idx[:, None] - idx[None, :]
    decay_mask = jnp.where(rel >= 0, jnp.exp(lg[..., None] * jnp.maximum(rel, 0.0)), 0.0)
    q_decay = jnp.exp(lg * (idx + 1.0))
    k_decay = jnp.exp(lg * (CHUNK - 1.0 - idx))
    chunk_decay = jnp.exp(lg[:, 0] * CHUNK)
    xs = tuple(_scan_major(_to_chunks(t)) for t in (q, k, v))

    def step(r_mat, inp):
        qj, kj, vj = inp
        s = jnp.einsum('bhtd,bhsd->bhts', qj, kj) * decay_mask
        o = jnp.einsum('bhts,bhse->bhte', s, vj) + q_decay[..., None] * jnp.einsum('bhtd,bhde->bhte', qj, r_mat)
        r_new = chunk_decay[:, None, None] * r_mat + jnp.einsum('bhsd,hs,bhse->bhde', kj, k_decay, vj)
        return r_new, o

    state, oc = lax.scan(step, state, xs)
    return _from_chunks(oc), state


def _gated_delta_scan(q, k, v, log_a, beta, state):
    qc, kc, vc = _to_chunks(q), _to_chunks(k), _to_chunks(v)
    g = jnp.cumsum(_to_chunks(log_a), axis=-1)
    bc = _to_chunks(beta)
    incl = jnp.tril(jnp.ones((CHUNK, CHUNK), dtype=bool))
    strict = jnp.tril(jnp.ones((CHUNK, CHUNK), dtype=bool), -1)
    decay = jnp.where(incl, jnp.exp(jnp.where(incl, g[..., :, None] - g[..., None, :], 0.0)), 0.0)
    kk = jnp.einsum('bhntd,bhnsd->bhnts', kc, kc)
    lower = jnp.where(strict, bc[..., :, None] * decay * kk, 0.0) + jnp.eye(CHUNK, dtype=F32)
    eg = jnp.exp(g)
    w_v = lax.linalg.triangular_solve(lower, bc[..., None] * vc, left_side=True, lower=True, unit_diagonal=True)
    w_k = lax.linalg.triangular_solve(lower, (bc * eg)[..., None] * kc, left_side=True, lower=True, unit_diagonal=True)
    qk = jnp.einsum('bhntd,bhnsd->bhnts', qc, kc) * decay
    k_end = jnp.exp(g[..., -1:] - g)
    g_end = eg[..., -1]
    xs = tuple(_scan_major(t) for t in (qc, kc, w_v, w_k, qk, eg, k_end, g_end))

    def step(s_mat, inp):
        qj, kj, wvj, wkj, qkj, egj, kej, gej = inp
        u = wvj - jnp.einsum('bhtd,bhde->bhte', wkj, s_mat)
        o = egj[..., None] * jnp.einsum('bhtd,bhde->bhte', qj, s_mat) + jnp.einsum('bhts,bhse->bhte', qkj, u)
        s_new = gej[..., None, None] * s_mat + jnp.einsum('bhs,bhsd,bhse->bhde', kej, kj, u)
        return s_new, o

    state, oc = lax.scan(step, state, xs)
    return _from_chunks(oc), state


def _flip_time(ts):
    return tuple(jnp.flip(t, axis=2) for t in ts)


def _bidir(scan_fns, ctx_dirs, lat_dirs, init):
    y_lat, y_ctx = None, None
    for d in range(2):
        ci, li = ctx_dirs[d], lat_dirs[d]
        if d == 1:
            ci, li = _flip_time(ci), _flip_time(li)
        h_c, state = scan_fns[d](*ci, init)
        h_l, _ = scan_fns[d](*li, state)
        if d == 1:
            h_c, h_l = jnp.flip(h_c, axis=2), jnp.flip(h_l, axis=2)
        y_lat = h_l if y_lat is None else y_lat + h_l
        y_ctx = h_c if y_ctx is None else y_ctx + h_c
    return y_lat, y_ctx


def _mlstm_branch(uc, ul, i_bias, f_bias):
    def prep(u):
        return (_heads(u['m_q']) * (HEAD_DIM ** -0.5), _heads(u['m_k']), _heads(u['m_v']))

    def gates(u, d):
        sl = slice(d * N_HEADS, (d + 1) * N_HEADS)
        log_i = _gate_heads(u['m_i'][..., sl]) + i_bias[d].astype(F32)[:, None]
        log_f = jax.nn.log_sigmoid(_gate_heads(u['m_f'][..., sl]) + f_bias[d].astype(F32)[:, None])
        return (log_i, log_f)

    b = ul['m_q'].shape[0]
    init = (jnp.zeros((b, N_HEADS, HEAD_DIM, HEAD_DIM), F32), jnp.zeros((b, N_HEADS, HEAD_DIM), F32),
            jnp.zeros((b, N_HEADS), F32))
    pc, pl = prep(uc), prep(ul)
    h_l, h_c = _bidir([_mlstm_scan, _mlstm_scan], [pc + gates(uc, d) for d in range(2)],
                      [pl + gates(ul, d) for d in range(2)], init)
    dt = ul['m_q'].dtype
    y_l = jax.nn.sigmoid(ul['m_o']) * _unheads(h_l).astype(dt)
    y_c = jax.nn.sigmoid(uc['m_o']) * _unheads(h_c).astype(dt)
    return y_l, y_c


def _retention_branch(uc, ul, log_gamma, rope):
    cos, sin = rope
    scale = HEAD_DIM ** -0.5
    pc = (_heads(uc['r_q']), _heads(uc['r_k']) * scale, _heads(uc['r_v']))
    pl = (_apply_rope(_heads(ul['r_q']), cos, sin), _apply_rope(_heads(ul['r_k']), cos, sin) * scale, _heads(ul['r_v']))
    b = ul['r_q'].shape[0]
    init = jnp.zeros((b, N_HEADS, HEAD_DIM, HEAD_DIM), F32)
    fns = [functools.partial(_retention_scan, log_gamma=log_gamma[d]) for d in range(2)]
    h_l, h_c = _bidir(fns, [pc, pc], [pl, pl], init)
    dt = ul['r_q'].dtype
    return _unheads(h_l).astype(dt), _unheads(h_c).astype(dt)


def _attention_branch(uc, ul, q_norm_w, k_norm_w, rope, need_ctx):
    cos, sin = rope
    scale = HEAD_DIM ** -0.5

    def prep(u):
        return (_rms_norm(_heads(u['a_q']), q_norm_w), _rms_norm(_heads(u['a_k']), k_norm_w), _heads(u['a_v']))

    q_l, k_l, v_l = prep(ul)
    q_l, k_l = _apply_rope(q_l, cos, sin), _apply_rope(k_l, cos, sin)
    q_c, k_c, v_c = prep(uc)
    b, _, n, dh = q_l.shape
    groups = N_HEADS // KV_HEADS
    keys = jnp.concatenate([k_c, k_l], axis=2)
    vals = jnp.concatenate([v_c, v_l], axis=2)

    def attend(q_blk, k_all, v_all):
        s = jnp.einsum('bkgqd,bksd->bkgqs', q_blk, k_all).astype(F32) * scale
        p = jax.nn.softmax(s, axis=-1).astype(v_all.dtype)
        return jnp.einsum('bkgqs,bksd->bkgqd', p, v_all)

    n_blk = n // Q_BLOCK
    q_blocks = q_l.reshape(b, KV_HEADS, groups, n_blk, Q_BLOCK, dh).transpose(3, 0, 1, 2, 4, 5)
    o = lax.map(lambda qb: attend(qb, keys, vals), q_blocks)
    y_l = _unheads(o.transpose(1, 2, 3, 0, 4, 5).reshape(b, N_HEADS, n, dh))
    y_c = None
    if need_ctx:
        n_c = q_c.shape[2]
        o_c = attend(q_c.reshape(b, KV_HEADS, groups, n_c, dh), k_c, v_c)
        y_c = _unheads(o_c.reshape(b, N_HEADS, n_c, dh))
    return y_l, y_c


def _deltanet_branch(uc, ul, conv_w, a_log, dt_bias):
    def prep(u):
        qkv = jax.nn.silu(_centred_dwconv(u['d_qkv'], conv_w))
        q, k, v = jnp.split(qkv, 3, axis=-1)
        return (_l2_norm(_heads(q)) * (HEAD_DIM ** -0.5), _l2_norm(_heads(k)), _heads(v))

    def gates(u, d):
        sl = slice(d * N_HEADS, (d + 1) * N_HEADS)
        dt_soft = jax.nn.softplus(_gate_heads(u['d_a'][..., sl]) + dt_bias[d].astype(F32)[:, None])
        log_a = -jnp.exp(a_log[d].astype(F32))[:, None] * dt_soft
        beta = jax.nn.sigmoid(_gate_heads(u['d_b'][..., sl]))
        return (log_a, beta)

    b = ul['d_qkv'].shape[0]
    init = jnp.zeros((b, N_HEADS, HEAD_DIM, HEAD_DIM), F32)
    pc, pl = prep(uc), prep(ul)
    h_l, h_c = _bidir([_gated_delta_scan, _gated_delta_scan], [pc + gates(uc, d) for d in range(2)],
                      [pl + gates(ul, d) for d in range(2)], init)
    dt = ul['d_qkv'].dtype
    return _unheads(h_l).astype(dt), _unheads(h_c).astype(dt)


def _merge(u, y_m, y_r, y_a, y_d, head_norm_w):
    return jnp.concatenate([
        _head_rms(y_m, head_norm_w[:GROUP_W]) * jax.nn.silu(u['m_z']),
        _head_rms(y_r, head_norm_w[GROUP_W:2 * GROUP_W]) * jax.nn.silu(u['r_z']),
        y_a * jax.nn.silu(u['a_z']),
        _head_rms(y_d, head_norm_w[2 * GROUP_W:]) * jax.nn.silu(u['d_z']),
    ], axis=-1)


def _layer(x, xc, c_silu, cc_silu, ada_w, ada_b, pre_w, post_w, w_in, w_out, m_ib, m_fb, r_lg,
           qn_w, kn_w, conv_w, a_log, dt_bias, hn_w, rope, need_ctx):
    mod_l = (c_silu @ ada_w + ada_b)[:, None, :]
    mod_c = cc_silu @ ada_w + ada_b
    sh_l, sc_l, gt_l = jnp.split(mod_l, 3, axis=-1)
    sh_c, sc_c, gt_c = jnp.split(mod_c, 3, axis=-1)
    h_l = _rms_norm(x, pre_w) * (1.0 + sc_l) + sh_l
    h_c = _rms_norm(xc, pre_w) * (1.0 + sc_c) + sh_c
    ul = _split_cols(h_l @ w_in)
    uc = _split_cols(h_c @ w_in)
    m_l, m_c = _mlstm_branch(uc, ul, m_ib, m_fb)
    r_l, r_c = _retention_branch(uc, ul, r_lg, rope)
    a_l, a_c = _attention_branch(uc, ul, qn_w, kn_w, rope, need_ctx)
    d_l, d_c = _deltanet_branch(uc, ul, conv_w, a_log, dt_bias)
    x = x + gt_l * _rms_norm(_merge(ul, m_l, r_l, a_l, d_l, hn_w) @ w_out, post_w)
    if need_ctx:
        xc = xc + gt_c * _rms_norm(_merge(uc, m_c, r_c, a_c, d_c, hn_w) @ w_out, post_w)
    return x, xc


def setup_inputs(seed: int = 0) -> dict:
    key = jax.random.key(seed)
    ks = jax.random.split(key, 20)

    def nrm(k, shape, s):
        return jax.random.normal(k, shape, F32) * s

    x = nrm(ks[0], (BATCH, SEQ, D_MODEL), 1.0)
    c = nrm(ks[1], (BATCH, D_MODEL), 1.0)
    ctx = nrm(ks[2], (BATCH, CTX_LEN, D_MODEL), 1.0)
    c_ctx = nrm(ks[3], (D_MODEL,), 1.0)
    ada_w = nrm(ks[4], (DEPTH, D_MODEL, 3 * D_MODEL), D_MODEL ** -0.5)
    ada_b = nrm(ks[5], (DEPTH, 3 * D_MODEL), 0.02)
    pre_norm_w = 1.0 + nrm(ks[6], (DEPTH, D_MODEL), 0.05)
    post_norm_w = 1.0 + nrm(ks[7], (DEPTH, D_MODEL), 0.05)
    w_in = nrm(ks[8], (DEPTH, D_MODEL, IN_W), D_MODEL ** -0.5)
    w_out = nrm(ks[9], (DEPTH, MIX_W, D_MODEL), MIX_W ** -0.5)
    mlstm_i_bias = nrm(ks[10], (DEPTH, 2, N_HEADS), 0.1)
    mlstm_f_bias = jnp.linspace(3.0, 6.0, N_HEADS, dtype=F32) + nrm(ks[11], (DEPTH, 2, N_HEADS), 0.1)
    base_lg = jnp.log(1.0 - 2.0 ** (-5.0 - jnp.arange(N_HEADS, dtype=F32)))
    ret_log_gamma = base_lg * jnp.exp(nrm(ks[12], (DEPTH, 2, N_HEADS), 0.1))
    attn_q_norm_w = 1.0 + nrm(ks[13], (DEPTH, HEAD_DIM), 0.05)
    attn_k_norm_w = 1.0 + nrm(ks[14], (DEPTH, HEAD_DIM), 0.05)
    dn_conv_w = nrm(ks[15], (DEPTH, CONV_K, 3 * GROUP_W), CONV_K ** -0.5)
    dn_a_log = jnp.log(jax.random.uniform(ks[16], (DEPTH, 2, N_HEADS), F32, 1.0, 16.0))
    dt0 = jnp.exp(jax.random.uniform(ks[17], (DEPTH, 2, N_HEADS), F32, math.log(1e-3), math.log(1e-1)))
    dn_dt_bias = dt0 + jnp.log(-jnp.expm1(-dt0))
    head_norm_w = 1.0 + nrm(ks[18], (DEPTH, 3 * GROUP_W), 0.05)
    return {'x': x, 'c': c, 'ctx': ctx, 'c_ctx': c_ctx, 'ada_w': ada_w, 'ada_b': ada_b,
            'pre_norm_w': pre_norm_w, 'post_norm_w': post_norm_w, 'w_in': w_in, 'w_out': w_out,
            'mlstm_i_bias': mlstm_i_bias, 'mlstm_f_bias': mlstm_f_bias, 'ret_log_gamma': ret_log_gamma,
            'attn_q_norm_w': attn_q_norm_w, 'attn_k_norm_w': attn_k_norm_w, 'dn_conv_w': dn_conv_w,
            'dn_a_log': dn_a_log, 'dn_dt_bias': dn_dt_bias, 'head_norm_w': head_norm_w}


def reference(x, c, ctx, c_ctx, ada_w, ada_b, pre_norm_w, post_norm_w, w_in, w_out, mlstm_i_bias,
              mlstm_f_bias, ret_log_gamma, attn_q_norm_w, attn_k_norm_w, dn_conv_w, dn_a_log,
              dn_dt_bias, head_norm_w):
    n_tokens = x.shape[1]
    rows = n_tokens // GRID_W
    rope = _axial_rope_tables(rows)
    c_silu = jax.nn.silu(c)
    cc_silu = jax.nn.silu(c_ctx)
    xc = ctx
    for layer in range(DEPTH):
        x, xc = _layer(x, xc, c_silu, cc_silu, ada_w[layer], ada_b[layer], pre_norm_w[layer],
                       post_norm_w[layer], w_in[layer], w_out[layer], mlstm_i_bias[layer],
                       mlstm_f_bias[layer], ret_log_gamma[layer], attn_q_norm_w[layer],
                       attn_k_norm_w[layer], dn_conv_w[layer], dn_a_log[layer], dn_dt_bias[layer],
                       head_norm_w[layer], rope, layer < DEPTH - 1)
    return x
```

```cpp
#include <hip/hip_runtime.h>
#include <cstdio>
#include <cstdint>
#include <hip/hip_cooperative_groups.h>
namespace cg = cooperative_groups;

typedef unsigned short bf16_t;
#define DI __device__ __forceinline__

constexpr int DM = 2048, NB = 4, SEQ = 4096, CTX = 256, TOK = SEQ + CTX, MROWS = NB * TOK;
constexpr int NIN = 8224, NU = 8448, HD = 128, NH = 4, GW = 512, DEPTH = 2;
constexpr float EPS = 1e-6f;
constexpr float QSCALE = 0.08838834764831845f;
constexpr int UC_MQ = 0, UC_MK = 512, UC_MV = 1024, UC_MO = 1536, UC_MZ = 2048, UC_RQ = 2560, UC_RK = 3072, UC_RV = 3584, UC_RZ = 4096,
              UC_AQ = 4608, UC_AK = 5120, UC_AV = 5376, UC_AZ = 5632, UC_DQ = 6144, UC_DZ = 7680, UC_MI = 8192, UC_MF = 8200, UC_DA = 8208, UC_DB = 8216;
constexpr int MG_M = 0, MG_R = 512, MG_A = 1024, MG_D = 1536;

constexpr size_t MiB = 1u << 20;
constexpr size_t WS_CTL = 0;
constexpr size_t WS_MOD = 64 * 1024;
constexpr size_t WS_ROPE = 512 * 1024;
constexpr size_t WS_WIN = 1 * MiB;
constexpr size_t WS_WOUT = WS_WIN + (size_t)1 * NU * DM * 2;
constexpr size_t WS_HB = WS_WOUT + (size_t)2 * DM * DM * 2;
constexpr size_t WS_XC = WS_HB + (size_t)MROWS * DM * 2;
constexpr size_t WS_DQ = WS_XC + (size_t)NB * CTX * DM * 4;
constexpr size_t WS_TB = WS_DQ + (size_t)MROWS * 1536 * 2;
constexpr size_t WS_U = WS_TB + (size_t)NB * NH * 2 * (TOK / 64) * 4096 * 2;
constexpr size_t WS_GP = WS_U + (size_t)MROWS * NU * 2;
constexpr size_t WS_CK = WS_GP + (size_t)MROWS * 56 * 4;
constexpr size_t WS_CKN = WS_CK + (size_t)96 * 8 * 16384 * 2;
constexpr size_t WS_YC = WS_CKN + (size_t)96 * 8 * 132 * 4;
constexpr size_t WS_END = WS_YC + (size_t)NB * CTX * DM * 2;
constexpr int GPW = 56;

struct Params {
  const float *x, *c, *ctx, *c_ctx, *ada_w, *ada_b, *pre_w, *post_w, *w_in, *w_out, *m_ib, *m_fb, *r_lg, *qn_w, *kn_w, *conv_w, *a_log, *dt_bias, *hn_w;
  float* out; unsigned char* ws;
};

DI int opq_tid() { int t = (int)threadIdx.x; asm volatile("" : "+v"(t)); return t; }
DI float bf2f(bf16_t v) { return __uint_as_float(((unsigned)v) << 16); }
DI bf16_t f2bf(float f) { unsigned u = __float_as_uint(f); return (bf16_t)((u + 0x7fffu + ((u >> 16) & 1u)) >> 16); }
DI float wave_sum(float v) {
#pragma unroll
  for (int o = 1; o < 64; o <<= 1) v += __shfl_xor(v, o);
  return v;
}
DI float siluf(float x) { return x * __builtin_amdgcn_rcpf(1.f + __expf(-x)); }
DI float sigmoidf(float x) { return __builtin_amdgcn_rcpf(1.f + __expf(-x)); }
DI float softplusf(float x) { return x > 20.f ? x : log1pf(__expf(x)); }
DI float logsigmoidf(float x) { return x < -20.f ? x : -log1pf(__expf(-x)); }
DI int ucol_src(int n) { return n < 2560 ? n : (n < 8192 ? n + 16 : (n < 8208 ? 2560 + (n - 8192) : (n < 8224 ? n : -1))); }


namespace pg8 {
#define PG8_LAS __attribute__((address_space(3)))
typedef unsigned short bf16_t;
typedef short bf16x8 __attribute__((ext_vector_type(8)));
typedef float f32x4 __attribute__((ext_vector_type(4)));
typedef unsigned u32x4 __attribute__((ext_vector_type(4)));
constexpr int BM = 256, BK = 64, HALF = 128, HTB = HALF * BK * 2  , STAGE_BYTES = 8 * HTB, NXCD = 8, WGM = 8;

__host__ __device__ __forceinline__ int lds_byte(int r, int c) { const int st = (r >> 4) * 2 + (c >> 5), rr = r & 15, cc = c & 31, ob = rr * 64 + cc * 2; return st * 1024 + (ob ^ (((ob >> 9) & 1) << 5)); }
__host__ __device__ __forceinline__ void stage_rc(int b, int& R, int& C) { const int st = b / 1024, sb = b % 1024, swz = sb ^ (((sb >> 9) & 1) << 5); R = (st >> 1) * 16 + swz / 64; C = (st & 1) * 32 + (swz % 64) / 2; }
__host__ __device__ __forceinline__ int perm32(int rho) { const int n = rho >> 4, i = rho & 15; return 8 * (i >> 2) + 4 * n + (i & 3); }

struct Unit { int pm, pn; };
struct Gemm { const bf16_t* A; const bf16_t* Bt; int M, N, K; };

struct StaticOrder {
    int nM, nN, nwg, G, c, skip;
    unsigned* sig;
    __host__ __device__ void init(int M, int N, int G_, int c_, int skip_ = 0, unsigned* sig_ = nullptr) { nM = M / BM; nN = N / BM; nwg = nM * nN; G = G_; c = c_; skip = skip_; sig = sig_; }
    __host__ __device__ bool next(int i, Unit& u) const {
        const long L = (long)i * G + c; if (L >= nwg) return false;
        int wgid = (int)L; { const int q = nwg / NXCD, r = nwg % NXCD, xcd = wgid % NXCD, off = wgid / NXCD; wgid = (xcd < r ? xcd * (q + 1) : r * (q + 1) + (xcd - r) * q) + off; }
        const int nig = WGM * nN, gid = wgid / nig, fm = gid * WGM, gsz = (nM - fm) < WGM ? (nM - fm) : WGM;
        u.pm = fm + ((wgid % nig) % gsz); u.pn = (wgid % nig) / gsz; if (skip == 1) u.pm += u.pm / 16 + 1;
        if (skip == 2) { u.pm = u.pm < 4 ? 17 * u.pm : (u.pm - 4) + (u.pm - 4) / 16 + 1; u.pn = u.pn < 6 ? 24 + u.pn : (u.pn == 6 ? 32 : (u.pn < 31 ? u.pn - 7 : u.pn - 1)); }
        return true;
    }
    __device__ __forceinline__ void a_ready(const Unit&) const {}
    __device__ __forceinline__ void done(const Unit& u) const {
        if (skip == 2 && (u.pm % 17) == 0 && ((u.pn >= 24 && u.pn < 30) || u.pn == 32)) {
            asm volatile("s_waitcnt vmcnt(0)" ::: "memory"); __syncthreads();
            if (threadIdx.x == 0) { __builtin_amdgcn_fence(__ATOMIC_RELEASE, "agent"); __hip_atomic_fetch_add(sig, 1u, __ATOMIC_RELAXED, __HIP_MEMORY_SCOPE_AGENT); } }
    }
};


struct OneTile { int pm, pn;
    __device__ __forceinline__ bool next(int i, Unit& u) const { if (i) return false; u.pm = pm; u.pn = pn; return true; }
    __device__ __forceinline__ void a_ready(const Unit&) const {}
    __device__ __forceinline__ void done(const Unit&) const {}
};

__device__ __forceinline__ unsigned cvt_pk_bf16(float lo, float hi) { unsigned r; asm volatile("v_cvt_pk_bf16_f32 %0, %1, %2" : "=v"(r) : "v"(lo), "v"(hi)); return r; }
struct EpiBf16 {
    static constexpr bool PERM = true, AFTER_DRAIN = false;
    bf16_t* O; int ldc; int actmode;
    __device__ __forceinline__ void operator()(const f32x4 (&acc)[2][2][4][2], const Unit& u, int wr, int wc, int fr, int fq) const {
        const int row0 = u.pm * BM + wr * 64 + fr; const int col0 = u.pn * BM + wc * 32 + 8 * fq;
        int act = 0;
        if (actmode) { const int pn = u.pn; if (pn == 6 || pn == 7) act = 2; else if (pn == 8 || pn == 9 || pn == 16 || pn == 17 || pn == 22 || pn == 23 || pn == 30 || pn == 31) act = 1; }
#pragma unroll
        for (int ai = 0; ai < 2; ++ai)
#pragma unroll
            for (int m = 0; m < 4; ++m) { bf16_t* rowp = O + (size_t)(row0 + ai * HALF + m * 16) * ldc + col0;
#pragma unroll
                for (int bj = 0; bj < 2; ++bj) { f32x4 v0 = acc[ai][bj][m][0], v1 = acc[ai][bj][m][1];
                    if (act) {
#pragma unroll
                        for (int e = 0; e < 4; ++e) { const float s0 = __builtin_amdgcn_rcpf(1.f + __expf(-v0[e])), s1 = __builtin_amdgcn_rcpf(1.f + __expf(-v1[e])); v0[e] = act == 1 ? v0[e] * s0 : s0; v1[e] = act == 1 ? v1[e] * s1 : s1; } }
                    u32x4 w; w.x = cvt_pk_bf16(v0[0], v0[1]); w.y = cvt_pk_bf16(v0[2], v0[3]); w.z = cvt_pk_bf16(v1[0], v1[1]); w.w = cvt_pk_bf16(v1[2], v1[3]);
                    *(u32x4*)(rowp + bj * HALF) = w; } }
    }
};

template <class Epi, class Sched, bool ALIGN_EPI = false, bool SP2 = false>
__device__ __forceinline__ void gemm_phase(PG8_LAS unsigned char* lds, const Gemm g, const Sched& S, const Epi& E) {
    const int tid = opq_tid(), wid = __builtin_amdgcn_readfirstlane(tid >> 6), lane = tid & 63, wr = wid >> 2, wc = wid & 3, fr = lane & 15, fq = lane >> 4;
    const int K = g.K, nt = K / BK;
    unsigned voffA[2], voffB[2];
#pragma unroll
    for (int i = 0; i < 2; ++i) { int R, C; stage_rc(tid * 16 + i * 8192, R, C); const int Rb = Epi::PERM ? ((R & ~31) + perm32(R & 31)) : R;
        voffA[i] = (unsigned)(R * K + C) * 2u; voffB[i] = (unsigned)(Rb * K + C) * 2u; }
    const size_t kstep = (size_t)(BK * 2);
    const size_t hstep = (size_t)HALF * K * 2;
    const size_t tstep = 2 * hstep;
    const unsigned ldsw = (unsigned)wid * 1024u;
    const int aoff = lds_byte(wr * 64 + fr, fq * 8), boff = lds_byte(wc * 32 + fr, fq * 8);
#define PG8_SA(b, h) (((b) * 2 + (h)) * HTB)
#define PG8_SB(b, h) ((4 + (b) * 2 + (h)) * HTB)
#define PG8_STAGE(bufoff, gbase, voff) do { _Pragma("unroll") for (int _i = 0; _i < 2; ++_i) \
        __builtin_amdgcn_global_load_lds((const unsigned*)((const char*)(gbase) + (voff)[_i]), (PG8_LAS unsigned*)(lds + (bufoff) + ldsw + _i * 8192), 16, 0, 0); } while (0)
#define PG8_LDA(dst, b, h) do { _Pragma("unroll") for (int m = 0; m < 4; ++m) _Pragma("unroll") for (int k = 0; k < 2; ++k) dst[m][k] = *(const PG8_LAS bf16x8*)(lds + PG8_SA(b, h) + aoff + m * 2048 + k * 1024); } while (0)
#define PG8_LDB(dst, b, h) do { _Pragma("unroll") for (int n = 0; n < 2; ++n) _Pragma("unroll") for (int k = 0; k < 2; ++k) dst[n][k] = *(const PG8_LAS bf16x8*)(lds + PG8_SB(b, h) + boff + n * 2048 + k * 1024); } while (0)
#define PG8_MMA(ai, bj, At, Bt) do { __builtin_amdgcn_s_setprio(1); _Pragma("unroll") for (int m = 0; m < 4; ++m) _Pragma("unroll") for (int n = 0; n < 2; ++n) _Pragma("unroll") for (int k = 0; k < 2; ++k) \
        acc[ai][bj][m][n] = __builtin_amdgcn_mfma_f32_16x16x32_bf16(Bt[n][k], At[m][k], acc[ai][bj][m][n], 0, 0, 0); __builtin_amdgcn_s_setprio(0); } while (0)
#define PG8_WAIT_V(n) asm volatile("s_waitcnt vmcnt(" #n ")" ::: "memory")
#define PG8_WAIT_L(n) asm volatile("s_waitcnt lgkmcnt(" #n ")" ::: "memory")
#define PG8_BAR __builtin_amdgcn_s_barrier()
#define PG8_SCHED __builtin_amdgcn_sched_barrier(0)
    Unit cur, nxt; int ui = 0;
    if (!S.next(0, cur)) return;
    f32x4 acc[2][2][4][2];
#pragma unroll
    for (int a = 0; a < 2; ++a)
#pragma unroll
        for (int b = 0; b < 2; ++b)
#pragma unroll
            for (int m = 0; m < 4; ++m)
#pragma unroll
                for (int n = 0; n < 2; ++n) acc[a][b][m][n] = (f32x4){0.f, 0.f, 0.f, 0.f};
    bf16x8 At[4][2], B0[2][2], B1[2][2];
    const char* cA = (const char*)g.A + (size_t)cur.pm * tstep; const char* cB = (const char*)g.Bt + (size_t)cur.pn * tstep;
    S.a_ready(cur);
    if constexpr (SP2) {
        PG8_STAGE(PG8_SB(0, 0), cB, voffB); PG8_STAGE(PG8_SB(0, 1), cB + hstep, voffB); PG8_STAGE(PG8_SA(0, 0), cA, voffA); PG8_STAGE(PG8_SA(0, 1), cA + hstep, voffA);
        if (wr == 1) PG8_BAR;
        PG8_WAIT_V(2); PG8_BAR;
        PG8_STAGE(PG8_SB(1, 0), cB + kstep, voffB); PG8_STAGE(PG8_SA(1, 0), cA + kstep, voffA); PG8_STAGE(PG8_SB(1, 1), cB + hstep + kstep, voffB);
        PG8_WAIT_V(6); PG8_BAR;
    } else {
        PG8_STAGE(PG8_SB(0, 0), cB, voffB); PG8_STAGE(PG8_SA(0, 0), cA, voffA); PG8_STAGE(PG8_SB(0, 1), cB + hstep, voffB); PG8_STAGE(PG8_SA(0, 1), cA + hstep, voffA);
        if (wr == 1) PG8_BAR;
        PG8_WAIT_V(4); PG8_BAR;
        PG8_STAGE(PG8_SB(1, 0), cB + kstep, voffB); PG8_STAGE(PG8_SA(1, 0), cA + kstep, voffA); PG8_STAGE(PG8_SB(1, 1), cB + hstep + kstep, voffB);
        PG8_WAIT_V(6); PG8_BAR;
    }
    for (;;) {
        const bool has_next = S.next(ui + 1, nxt);
        const char* nA = has_next ? (const char*)g.A + (size_t)nxt.pm * tstep : cA; const char* nB = has_next ? (const char*)g.Bt + (size_t)nxt.pn * tstep : cB;
        for (int t = 0; t < nt; t += 2) {
            const bool last = (t == nt - 2);
            const char* a1 = cA + (size_t)(t + 1) * kstep;
            const char* a2 = last ? nA : cA + (size_t)(t + 2) * kstep; const char* b2 = last ? nB : cB + (size_t)(t + 2) * kstep;
            const char* a3 = a2 + kstep; const char* b3 = b2 + kstep;
            if (last && has_next) S.a_ready(nxt);
            if constexpr (SP2) {
            PG8_LDB(B0, 0, 0); PG8_LDB(B1, 0, 1); PG8_SCHED; PG8_LDA(At, 0, 0); PG8_STAGE(PG8_SA(1, 1), a1 + hstep, voffA);
            PG8_WAIT_V(8); PG8_WAIT_L(0); PG8_BAR; PG8_MMA(0, 0, At, B0); PG8_MMA(0, 1, At, B1); PG8_BAR; PG8_SCHED;
            PG8_LDA(At, 0, 1); PG8_STAGE(PG8_SB(0, 0), b2, voffB); PG8_STAGE(PG8_SB(0, 1), b2 + hstep, voffB); PG8_STAGE(PG8_SA(0, 0), a2, voffA);
            PG8_WAIT_V(8); PG8_WAIT_L(0); PG8_BAR; PG8_MMA(1, 0, At, B0); PG8_MMA(1, 1, At, B1); PG8_BAR; PG8_SCHED;
            PG8_LDB(B0, 1, 0); PG8_LDB(B1, 1, 1); PG8_SCHED; PG8_LDA(At, 1, 0); PG8_STAGE(PG8_SA(0, 1), a2 + hstep, voffA);
            PG8_WAIT_V(8); PG8_WAIT_L(0); PG8_BAR; PG8_MMA(0, 0, At, B0); PG8_MMA(0, 1, At, B1); PG8_BAR; PG8_SCHED;
            PG8_LDA(At, 1, 1); PG8_STAGE(PG8_SB(1, 0), b3, voffB); PG8_STAGE(PG8_SB(1, 1), b3 + hstep, voffB); PG8_STAGE(PG8_SA(1, 0), a3, voffA);
            PG8_WAIT_V(8); PG8_WAIT_L(0); PG8_BAR; PG8_MMA(1, 0, At, B0); PG8_MMA(1, 1, At, B1); PG8_BAR; PG8_SCHED;
            } else {
            PG8_LDB(B0, 0, 0); PG8_SCHED; PG8_LDA(At, 0, 0); PG8_STAGE(PG8_SA(1, 1), a1 + hstep, voffA);
            PG8_WAIT_L(8); PG8_BAR; PG8_WAIT_L(0); PG8_MMA(0, 0, At, B0); PG8_BAR; PG8_SCHED;
            PG8_LDB(B1, 0, 1); PG8_STAGE(PG8_SB(0, 0), b2, voffB);
            PG8_BAR; PG8_WAIT_L(0); PG8_MMA(0, 1, At, B1); PG8_BAR;
            PG8_LDA(At, 0, 1); PG8_STAGE(PG8_SA(0, 0), a2, voffA);
            PG8_BAR; PG8_WAIT_L(0); PG8_MMA(1, 0, At, B0); PG8_BAR; PG8_SCHED;
            PG8_STAGE(PG8_SB(0, 1), b2 + hstep, voffB);
            PG8_WAIT_V(6); PG8_BAR; PG8_MMA(1, 1, At, B1); PG8_BAR;
            PG8_LDB(B0, 1, 0); PG8_SCHED; PG8_LDA(At, 1, 0); PG8_STAGE(PG8_SA(0, 1), a2 + hstep, voffA);
            PG8_WAIT_L(8); PG8_BAR; PG8_WAIT_L(0); PG8_MMA(0, 0, At, B0); PG8_BAR; PG8_SCHED;
            PG8_LDB(B1, 1, 1); PG8_STAGE(PG8_SB(1, 0), b3, voffB);
            PG8_BAR; PG8_WAIT_L(0); PG8_MMA(0, 1, At, B1); PG8_BAR;
            PG8_LDA(At, 1, 1); PG8_STAGE(PG8_SA(1, 0), a3, voffA);
            PG8_BAR; PG8_WAIT_L(0); PG8_MMA(1, 0, At, B0); PG8_BAR; PG8_SCHED;
            PG8_STAGE(PG8_SB(1, 1), b3 + hstep, voffB);
            PG8_WAIT_V(6); PG8_BAR; PG8_MMA(1, 1, At, B1); PG8_BAR;
            }
        }
        if constexpr (ALIGN_EPI) { if (wr == 0) PG8_BAR; }
        if constexpr (!Epi::AFTER_DRAIN) { E(acc, cur, wr, wc, fr, fq); S.done(cur); }
        if (!has_next) break;
#pragma unroll
        for (int a = 0; a < 2; ++a)
#pragma unroll
            for (int b = 0; b < 2; ++b)
#pragma unroll
                for (int m = 0; m < 4; ++m)
#pragma unroll
                    for (int n = 0; n < 2; ++n) acc[a][b][m][n] = (f32x4){0.f, 0.f, 0.f, 0.f};
        cur = nxt; cA = nA; cB = nB; ++ui;
        if constexpr (ALIGN_EPI) { if (wr == 1) PG8_BAR; }
    }
    PG8_WAIT_V(0);
    if constexpr (!ALIGN_EPI) { if (wr == 0) PG8_BAR; }
    PG8_BAR;
    if constexpr (Epi::AFTER_DRAIN) { E.fused(acc, cur, wr, wc, fr, fq, lds, wid, lane); S.done(cur); }
#undef PG8_SA
#undef PG8_SB
#undef PG8_STAGE
#undef PG8_LDA
#undef PG8_LDB
#undef PG8_MMA
#undef PG8_WAIT_V
#undef PG8_WAIT_L
#undef PG8_BAR
#undef PG8_SCHED
}
}

namespace scn {
typedef short bf16x8 __attribute__((ext_vector_type(8)));
typedef short bf16x4 __attribute__((ext_vector_type(4)));
typedef float f32x4 __attribute__((ext_vector_type(4)));
typedef unsigned u32x4 __attribute__((ext_vector_type(4)));
typedef float f32x2_t __attribute__((ext_vector_type(2))); typedef __bf16 bf16x2_t __attribute__((ext_vector_type(2)));
constexpr int QS = 136, KS_ = 144, TS = 72, OSS = 132;
constexpr int QSB = QS * 2, KSB = KS_ * 2, TSB = TS * 2;
constexpr int L_Q = 0, L_K = L_Q + 64 * QSB, L_V = L_K + 64 * KSB, L_T = L_V + 64 * KSB, L_AS = L_T + 64 * TSB, L_OS = L_AS + 64 * TSB, L_G = L_OS + 64 * OSS * 4,
              L_N = L_G + 2 * 448 * 4, L_NP = L_N + 2 * 128 * 4, L_DEN = L_NP + 4 * 128 * 4, L_HN = L_DEN + 64 * 4, L_END = L_HN + 128 * 4;
constexpr int NCH = TOK / 64;
DI unsigned cvtpk(float lo, float hi) { f32x2_t v = {lo, hi}; bf16x2_t b = __builtin_convertvector(v, bf16x2_t); return __builtin_bit_cast(unsigned, b); }
DI bf16x8 pack2(f32x4 a, f32x4 b) { u32x4 w = {cvtpk(a[0], a[1]), cvtpk(a[2], a[3]), cvtpk(b[0], b[1]), cvtpk(b[2], b[3])}; return __builtin_bit_cast(bf16x8, w); }
DI int pcol(int c) { const int o = c & 31; return (c & ~31) + (o < 16 ? 8 * (o >> 2) + (o & 3) : 8 * ((o - 16) >> 2) + 4 + (o & 3)); }
DI int unpcol(int pos) { const int q = pos & 31, gg = q >> 3, j = q & 7; return (pos & ~31) + (j < 4 ? 4 * gg + j : 16 + 4 * gg + (j - 4)); }
DI bf16x8 ld_perm(const unsigned char* rowp, int kb, int g) { return *(const bf16x8*)(rowp + (kb * 32 + 8 * g) * 2); }
typedef short v4i16_t __attribute__((ext_vector_type(4)));
DI bf16x4 tr_read(const unsigned char* p) { return __builtin_bit_cast(bf16x4, __builtin_amdgcn_ds_read_tr16_b64_v4i16((__attribute__((address_space(3))) v4i16_t*)p)); }
DI bf16x8 tr_pair(const unsigned char* p, int rowstep16_bytes) { const bf16x4 lo = tr_read(p), hi = tr_read(p + rowstep16_bytes); return __builtin_shufflevector(lo, hi, 0, 1, 2, 3, 4, 5, 6, 7); }
DI float wave_psum(float v, int lane) {
#pragma unroll
  for (int o = 1; o < 64; o <<= 1) { const float u = __shfl_up(v, o); if (lane >= o) v += u; }
  return v;
}
DI float wave_pmax(float v, int lane) {
#pragma unroll
  for (int o = 1; o < 64; o <<= 1) { const float u = __shfl_up(v, o); if (lane >= o) v = fmaxf(v, u); }
  return v;
}
DI int row_of(int dir, int pos) { return dir == 0 ? pos : (pos < CTX ? CTX - 1 - pos : TOK + CTX - 1 - pos); }
#define MFMA16(a, b, c) __builtin_amdgcn_mfma_f32_16x16x32_bf16((a), (b), (c), 0, 0, 0)

template <int MIX>
DI void scan_task(const Params& p, const int layer, const int b, const int h, const int blk, unsigned char* lds) {
  const int tid = opq_tid(), lane = tid & 63, w = __builtin_amdgcn_readfirstlane(tid >> 6), c16 = lane & 15, g = lane >> 4;
  const bf16_t* U = (const bf16_t*)(p.ws + WS_U); bf16_t* MG = (bf16_t*)(p.ws + WS_HB);
  const bf16_t* src = MIX == 2 ? (const bf16_t*)(p.ws + WS_DQ) : U;
  constexpr int rstride = MIX == 2 ? 1536 : NU;
  const int qoff = (MIX == 0 ? UC_MQ : (MIX == 1 ? UC_RQ : 0)) + h * HD, koff = (MIX == 0 ? UC_MK : (MIX == 1 ? UC_RK : 512)) + h * HD, voff = (MIX == 0 ? UC_MV : (MIX == 1 ? UC_RV : 1024)) + h * HD;
  const int zc = (MIX == 0 ? UC_MZ : (MIX == 1 ? UC_RZ : UC_DZ)) + h * HD, mgc = (MIX == 0 ? MG_M : (MIX == 1 ? MG_R : MG_D)) + h * HD;
  const bf16_t* TB = (const bf16_t*)(p.ws + WS_TB) + (size_t)((b * NH + h) * 2) * NCH * 4096;
  float* nbuf = (float*)(lds + L_N); float* NP = (float*)(lds + L_NP); float* DEN = (float*)(lds + L_DEN); float* HN = (float*)(lds + L_HN);
  bf16_t* ASl = (bf16_t*)(lds + L_AS); float* OSl = (float*)(lds + L_OS);
  const int trb = (4 * g + (c16 >> 2)) * KSB + (c16 & 3) * 8;
  const int trk = (4 * g + (c16 >> 2)) * KSB + (c16 & 3) * 16;
  const int nst = blk == 0 ? 4 : 8, blk1 = blk == 0 ? 0 : 9 - blk, c0 = blk == 0 ? 0 : 8 * blk - 4, c1 = blk1 == 0 ? 0 : 8 * blk1 - 4;
  const int seq0 = ((MIX * NB + b) * NH + h) * 2;
#define SCN_DIR(s_) ((s_) >= nst ? 1 : 0)
#define SCN_CC(s_) ((s_) >= nst ? c1 + (s_) - nst : c0 + (s_))
  f32x4 S[8];
#pragma unroll
  for (int i = 0; i < 8; ++i) S[i] = (f32x4){0.f, 0.f, 0.f, 0.f};
  u32x4 rq[2], rk[2], rv[2], rt; float ga = 0.f, gb = 0.f, gc = 0.f, gd = 0.f; float m_state = 0.f;
  rt = (u32x4){0u, 0u, 0u, 0u};

#define SCN_ISSUE(st_) do { const int dir_ = SCN_DIR(st_), cc_ = SCN_CC(st_);                                                             \
    _Pragma("unroll") for (int i_ = 0; i_ < 2; ++i_) { const int idx_ = tid + 512 * i_, t_ = idx_ >> 4, pc_ = idx_ & 15;                 \
      const size_t R_ = (size_t)b * TOK + row_of(dir_, 64 * cc_ + t_); const bf16_t* rp_ = src + R_ * rstride + pc_ * 8;                    \
      rq[i_] = *(const u32x4*)(rp_ + qoff); rk[i_] = *(const u32x4*)(rp_ + koff); rv[i_] = *(const u32x4*)(rp_ + voff); }                   \
    if (MIX == 2) rt = *(const u32x4*)(TB + (size_t)(dir_ * NCH + cc_) * 4096 + (tid >> 3) * 64 + (tid & 7) * 8);                            \
    if (w == 0 && MIX != 1) { const size_t R_ = (size_t)b * TOK + row_of(dir_, 64 * cc_ + lane); const float* gp_ = (const float*)(p.ws + WS_GP) + R_ * GPW;   \
      if (MIX == 0) { gp_ += (dir_ * 4 + h) * 3; ga = gp_[0]; gb = gp_[1]; gc = gp_[2]; }                                                  \
      else { const f32x4 q_ = *(const f32x4*)(gp_ + 24 + (dir_ * 4 + h) * 4); ga = q_[0]; gb = q_[1]; gc = q_[2]; gd = q_[3]; } } } while (0)

#define SCN_COMMIT(st_) do { const int dir_ = SCN_DIR(st_); float* gt_ = (float*)(lds + L_G) + ((st_) & 1) * 448;                          \
    _Pragma("unroll") for (int i_ = 0; i_ < 2; ++i_) { const int idx_ = tid + 512 * i_, t_ = idx_ >> 4, pc_ = idx_ & 15;                 \
      const int po_ = ((pc_ >> 2) * 32 + (pc_ & 1) * 16 + ((pc_ >> 1) & 1) * 4) * 2;                                                          \
      *(unsigned long long*)(lds + L_Q + t_ * QSB + po_) = (unsigned long long)rq[i_][0] | ((unsigned long long)rq[i_][1] << 32); *(unsigned long long*)(lds + L_Q + t_ * QSB + po_ + 16) = (unsigned long long)rq[i_][2] | ((unsigned long long)rq[i_][3] << 32); \
      *(unsigned long long*)(lds + L_K + t_ * KSB + po_) = (unsigned long long)rk[i_][0] | ((unsigned long long)rk[i_][1] << 32); *(unsigned long long*)(lds + L_K + t_ * KSB + po_ + 16) = (unsigned long long)rk[i_][2] | ((unsigned long long)rk[i_][3] << 32); \
      *(u32x4*)(lds + L_V + t_ * KSB + pc_ * 16) = rv[i_]; } \
    if (MIX == 2) *(u32x4*)(lds + L_T + (tid >> 3) * TSB + (tid & 7) * 16) = rt;                                                           \
    if (w == 0) { const int gi_ = layer * 8 + dir_ * 4 + h; float rowf_, colf_, alpha_, wv_, beta_ = 0.f, ninv_ = 0.f, cd_;                  \
      if (MIX == 0 && ((st_) == 0 || (st_) == nst)) { const int ck_ = ((st_) == 0 ? blk : blk1) - 1; m_state = ck_ >= 0 ? ((const float*)(p.ws + WS_CKN))[((size_t)(seq0 + dir_) * 8 + ck_) * 132 + 128] : 0.f; } \
      if (MIX == 0) { const float a_ = ga, run_ = fmaxf(m_state, gb); const float run63_ = __shfl(run_, 63), bend_ = __shfl(gc, 63);                 \
        rowf_ = -run_; colf_ = a_; alpha_ = __expf(m_state - run_); wv_ = __expf(a_ - run63_); ninv_ = __expf(-(gc + run_)); cd_ = __expf(m_state - run63_); m_state = bend_ + run63_; } \
      else if (MIX == 1) { const float lg_ = p.r_lg[gi_]; rowf_ = lg_ * (float)lane; colf_ = -rowf_; alpha_ = __expf(lg_ * (float)(lane + 1)); wv_ = __expf(lg_ * (float)(63 - lane)); cd_ = __expf(lg_ * 64.f); } \
      else { rowf_ = ga; colf_ = -ga; alpha_ = gb; wv_ = gc; beta_ = gd; cd_ = __shfl(gb, 63); }                                              \
      gt_[lane] = rowf_; gt_[64 + lane] = colf_; gt_[128 + lane] = alpha_; gt_[192 + lane] = wv_; gt_[256 + lane] = beta_; gt_[320 + lane] = ninv_; if (lane == 0) gt_[384] = cd_; } } while (0)

  if (tid < 256) nbuf[tid] = 0.f;
  if (tid < 128) HN[tid] = p.hn_w[layer * 1536 + (MIX == 0 ? 0 : (MIX == 1 ? 512 : 1024)) + h * HD + tid];
  SCN_ISSUE(0); SCN_COMMIT(0);
  for (int st = 0; st < 2 * nst; ++st) {
    const int dir = SCN_DIR(st), cc = SCN_CC(st);
    const float* gts = (const float*)(lds + L_G) + (st & 1) * 448;
    if (st == 0 || st == nst) {
      const int ck = (st == 0 ? blk : blk1) - 1;
      if (ck >= 0) { const unsigned long long* cp = (const unsigned long long*)(p.ws + WS_CK) + (((size_t)(seq0 + dir) * 8 + ck) * 8 + w) * 8 * 64 + lane;
#pragma unroll
        for (int i = 0; i < 8; ++i) { const unsigned long long q = cp[i * 64]; const unsigned lo = (unsigned)q, hi = (unsigned)(q >> 32);
          S[i] = (f32x4){__uint_as_float(lo << 16), __uint_as_float(lo & 0xffff0000u), __uint_as_float(hi << 16), __uint_as_float(hi & 0xffff0000u)}; }
      } else {
#pragma unroll
        for (int i = 0; i < 8; ++i) S[i] = (f32x4){0.f, 0.f, 0.f, 0.f}; }
      if (MIX == 0 && tid < 128) nbuf[(st & 1) * 128 + tid] = ck >= 0 ? ((const float*)(p.ws + WS_CKN))[((size_t)(seq0 + dir) * 8 + ck) * 132 + tid] : 0.f;
    }
    __syncthreads();
    if (st + 1 < 2 * nst) SCN_ISSUE(st + 1);
    { const int tb = w >> 1;
#pragma unroll
      for (int q2 = 0; q2 < 2; ++q2) { const int sb = 2 * (w & 1) + q2; f32x4 acc = (f32x4){0.f, 0.f, 0.f, 0.f};
        if (sb <= tb) {
          bf16x8 fa[4], fb[4];
#pragma unroll
          for (int kb = 0; kb < 4; ++kb) { fa[kb] = *(const bf16x8*)(lds + L_Q + (16 * tb + c16) * QSB + kb * 64 + g * 16); fb[kb] = *(const bf16x8*)(lds + L_K + (16 * sb + c16) * KSB + kb * 64 + g * 16); }
          __builtin_amdgcn_sched_barrier(0);
#pragma unroll
          for (int kb = 0; kb < 4; ++kb) acc = MFMA16(fa[kb], fb[kb], acc);
          const float cf = gts[64 + 16 * sb + c16]; const f32x4 rf = *(const f32x4*)(gts + 16 * tb + 4 * g);
#pragma unroll
          for (int r = 0; r < 4; ++r) { const int t = 16 * tb + 4 * g + r, s = 16 * sb + c16; acc[r] = (s <= t) ? acc[r] * __expf(rf[r] + cf) : 0.f; }
        }
#pragma unroll
        for (int r = 0; r < 4; ++r) ASl[(16 * tb + 4 * g + r) * TS + pcol(16 * sb + c16)] = (bf16_t)(cvtpk(acc[r], 0.f) & 0xffffu);
      } }
    __syncthreads();
    const int et = tid >> 3, epart = tid & 7; const size_t eR = (size_t)b * TOK + row_of(dir, 64 * cc + et);
    bf16_t* mp = MG + eR * DM + mgc + 16 * epart;
    u32x4 pp0, pp1, pz0, pz1, pg0, pg1;
    pp0 = pp1 = pz0 = pz1 = pg0 = pg1 = (u32x4){0u, 0u, 0u, 0u};
    if (dir == 1) { const bf16_t* Ur = U + eR * NU; pp0 = *(const u32x4*)mp; pp1 = *(const u32x4*)(mp + 8); pz0 = *(const u32x4*)(Ur + zc + 16 * epart); pz1 = *(const u32x4*)(Ur + zc + 16 * epart + 8);
      if (MIX == 0) { pg0 = *(const u32x4*)(Ur + UC_MO + h * HD + 16 * epart); pg1 = *(const u32x4*)(Ur + UC_MO + h * HD + 16 * epart + 8); } }
    {
      const float cd = gts[384];
      bf16x8 Sb[4];
#pragma unroll
      for (int kb = 0; kb < 4; ++kb) Sb[kb] = pack2(S[2 * kb], S[2 * kb + 1]);
      f32x4 X[4];
      bf16x8 Xb[2], Wb[2];
      if (MIX == 2) {
        f32x4 KS[4];
#pragma unroll
        for (int tb = 0; tb < 4; ++tb) { KS[tb] = (f32x4){0.f, 0.f, 0.f, 0.f};
#pragma unroll
          for (int kb = 0; kb < 4; ++kb) KS[tb] = MFMA16(ld_perm(lds + L_K + (16 * tb + c16) * KSB, kb, g), Sb[kb], KS[tb]); }
#pragma unroll
        for (int tb = 0; tb < 4; ++tb) { const f32x4 al = *(const f32x4*)(gts + 128 + 16 * tb + 4 * g), be = *(const f32x4*)(gts + 256 + 16 * tb + 4 * g);
          const bf16x4 vv = tr_read(lds + L_V + trb + (16 * tb) * KSB + 32 * w);
#pragma unroll
          for (int r = 0; r < 4; ++r) KS[tb][r] = be[r] * (bf2f((bf16_t)vv[r]) - al[r] * KS[tb][r]); }
        const bf16x8 Rb0 = pack2(KS[0], KS[1]), Rb1 = pack2(KS[2], KS[3]);
#pragma unroll
        for (int tb = 0; tb < 4; ++tb) { X[tb] = (f32x4){0.f, 0.f, 0.f, 0.f};
          X[tb] = MFMA16(ld_perm(lds + L_T + (16 * tb + c16) * TSB, 0, g), Rb0, X[tb]); X[tb] = MFMA16(ld_perm(lds + L_T + (16 * tb + c16) * TSB, 1, g), Rb1, X[tb]); }
        Xb[0] = pack2(X[0], X[1]); Xb[1] = pack2(X[2], X[3]);
#pragma unroll
        for (int tb = 0; tb < 4; ++tb) { const f32x4 wv = *(const f32x4*)(gts + 192 + 16 * tb + 4 * g); X[tb] = X[tb] * wv; }
        Wb[0] = pack2(X[0], X[1]); Wb[1] = pack2(X[2], X[3]);
      } else {
#pragma unroll
        for (int ks = 0; ks < 2; ++ks) { Xb[ks] = tr_pair(lds + L_V + trb + (32 * ks) * KSB + 32 * w, 16 * KSB);
          const f32x4 w0 = *(const f32x4*)(gts + 192 + 32 * ks + 4 * g), w1 = *(const f32x4*)(gts + 192 + 32 * ks + 16 + 4 * g);
          f32x4 x0, x1;
#pragma unroll
          for (int j = 0; j < 4; ++j) { x0[j] = bf2f((bf16_t)Xb[ks][j]) * w0[j]; x1[j] = bf2f((bf16_t)Xb[ks][4 + j]) * w1[j]; }
          Wb[ks] = pack2(x0, x1); }
      }
#pragma unroll
      for (int tb = 0; tb < 4; ++tb) { f32x4 in = (f32x4){0.f, 0.f, 0.f, 0.f}, it = (f32x4){0.f, 0.f, 0.f, 0.f};
#pragma unroll
        for (int kb = 0; kb < 4; ++kb) in = MFMA16(ld_perm(lds + L_Q + (16 * tb + c16) * QSB, kb, g), Sb[kb], in);
#pragma unroll
        for (int ks = 0; ks < 2; ++ks) it = MFMA16(ld_perm(lds + L_AS + (16 * tb + c16) * TSB, ks, g), Xb[ks], it);
        const f32x4 al = *(const f32x4*)(gts + 128 + 16 * tb + 4 * g);
#pragma unroll
        for (int r = 0; r < 4; ++r) OSl[(16 * tb + 4 * g + r) * OSS + 16 * w + c16] = al[r] * in[r] + it[r]; }
#pragma unroll
      for (int hh = 0; hh < 2; ++hh) {
        bf16x8 kf[8];
#pragma unroll
        for (int ii = 0; ii < 4; ++ii) { const int i = 4 * hh + ii; kf[2 * ii] = tr_pair(lds + L_K + trk + 64 * (i >> 1) + 8 * (i & 1), 16 * KSB); kf[2 * ii + 1] = tr_pair(lds + L_K + trk + 32 * KSB + 64 * (i >> 1) + 8 * (i & 1), 16 * KSB); S[i] = S[i] * cd; }
        __builtin_amdgcn_sched_barrier(0);
#pragma unroll
        for (int ii = 0; ii < 4; ++ii) { const int i = 4 * hh + ii; S[i] = MFMA16(kf[2 * ii], Wb[0], S[i]); S[i] = MFMA16(kf[2 * ii + 1], Wb[1], S[i]); }
        __builtin_amdgcn_sched_barrier(0);
      }
      if (MIX == 0) {
        { const int dk = tid & 127, part = tid >> 7; float a = 0.f; const bf16_t* kp = (const bf16_t*)(lds + L_K) + (16 * part) * KS_ + pcol(dk);
#pragma unroll
          for (int k = 0; k < 16; ++k) a += gts[192 + 16 * part + k] * bf2f(kp[k * KS_]);
          NP[part * 128 + dk] = a; }
        { const float* no = nbuf + (st & 1) * 128; const bf16_t* qrow = (const bf16_t*)(lds + L_Q) + et * QS + 16 * epart; float ds = 0.f, as = 0.f;
#pragma unroll
          for (int k = 0; k < 16; ++k) ds += bf2f(qrow[k]) * no[unpcol(16 * epart + k)];
#pragma unroll
          for (int k = 0; k < 8; ++k) as += bf2f(ASl[et * TS + 8 * epart + k]);
          float den = gts[128 + et] * ds + as; den += __shfl_xor(den, 1); den += __shfl_xor(den, 2); den += __shfl_xor(den, 4);
          if (epart == 0) DEN[et] = den; }
      }
    }
    __syncthreads();
    if (st + 1 < 2 * nst) SCN_COMMIT(st + 1);
    if (MIX == 0 && tid < 128) { const float* no = nbuf + (st & 1) * 128; float* nn = nbuf + ((st + 1) & 1) * 128;
      nn[tid] = gts[384] * no[tid] + (NP[tid] + NP[128 + tid]) + (NP[256 + tid] + NP[384 + tid]); }
    {
      float o[16];
#pragma unroll
      for (int k4 = 0; k4 < 4; ++k4) { const f32x4 v = *(const f32x4*)(OSl + et * OSS + 16 * epart + 4 * k4); o[4 * k4] = v[0]; o[4 * k4 + 1] = v[1]; o[4 * k4 + 2] = v[2]; o[4 * k4 + 3] = v[3]; }
      if (MIX == 0) { const float sc = QSCALE / fmaxf(fabsf(DEN[et] * QSCALE), gts[320 + et]);
#pragma unroll
        for (int k = 0; k < 16; ++k) o[k] *= sc; }
      if (dir == 0) { u32x4 w0, w1;
#pragma unroll
        for (int k = 0; k < 4; ++k) { w0[k] = cvtpk(o[2 * k], o[2 * k + 1]); w1[k] = cvtpk(o[8 + 2 * k], o[8 + 2 * k + 1]); }
        *(u32x4*)mp = w0; *(u32x4*)(mp + 8) = w1;
      } else {
        float ss = 0.f;
#pragma unroll
        for (int k = 0; k < 8; ++k) { const unsigned pw = k < 4 ? pp0[k] : pp1[k - 4]; o[2 * k] += __uint_as_float(pw << 16); o[2 * k + 1] += __uint_as_float(pw & 0xffff0000u); }
        if (MIX == 0) {
#pragma unroll
          for (int k = 0; k < 8; ++k) { const unsigned gw = k < 4 ? pg0[k] : pg1[k - 4]; o[2 * k] *= __uint_as_float(gw << 16); o[2 * k + 1] *= __uint_as_float(gw & 0xffff0000u); } }
#pragma unroll
        for (int k = 0; k < 16; ++k) ss += o[k] * o[k];
        ss += __shfl_xor(ss, 1); ss += __shfl_xor(ss, 2); ss += __shfl_xor(ss, 4);
        const float rs = rsqrtf(ss * (1.f / HD) + EPS);
        u32x4 w0, w1;
#pragma unroll
        for (int k = 0; k < 8; ++k) { const unsigned zw = k < 4 ? pz0[k] : pz1[k - 4]; const float za = __uint_as_float(zw << 16), zb = __uint_as_float(zw & 0xffff0000u);
          const float ya = o[2 * k] * rs * HN[16 * epart + 2 * k] * za, yb = o[2 * k + 1] * rs * HN[16 * epart + 2 * k + 1] * zb;
          if (k < 4) w0[k] = cvtpk(ya, yb); else w1[k - 4] = cvtpk(ya, yb); }
        *(u32x4*)mp = w0; *(u32x4*)(mp + 8) = w1;
      }
    }
  }
  __syncthreads();
#undef SCN_ISSUE
#undef SCN_COMMIT
#undef SCN_DIR
#undef SCN_CC
}

namespace lean {
constexpr int LB = 64 * scn::KSB * 2 + 64 * scn::TSB;
constexpr int L_G = 2 * LB, L_END = L_G + 2 * 448 * 4;
}
template <int MIX>
DI void scan_lean(const Params& p, const int layer, const int b, const int h, const int dir, unsigned char* lds) {
  const int tid = opq_tid(), lane = tid & 63, w = __builtin_amdgcn_readfirstlane(tid >> 6), c16 = lane & 15, g = lane >> 4;
  const bf16_t* U = (const bf16_t*)(p.ws + WS_U);
  const bf16_t* src = MIX == 2 ? (const bf16_t*)(p.ws + WS_DQ) : U;
  constexpr int rstride = MIX == 2 ? 1536 : NU;
  const int koff = (MIX == 0 ? UC_MK : (MIX == 1 ? UC_RK : 512)) + h * HD, voff = (MIX == 0 ? UC_MV : (MIX == 1 ? UC_RV : 1024)) + h * HD;
  const bf16_t* TB = (const bf16_t*)(p.ws + WS_TB) + (size_t)((b * NH + h) * 2 + dir) * NCH * 4096;
  const int trb = (4 * g + (c16 >> 2)) * KSB + (c16 & 3) * 8, trk = (4 * g + (c16 >> 2)) * KSB + (c16 & 3) * 16;
  const int seq = ((MIX * NB + b) * NH + h) * 2 + dir;
  const int gi = layer * 8 + dir * 4 + h;
  f32x4 S[8];
#pragma unroll
  for (int i = 0; i < 8; ++i) S[i] = (f32x4){0.f, 0.f, 0.f, 0.f};
  float nreg = 0.f, m_state = 0.f;
  u32x4 kA[2], vA[2], tA; float gA0 = 0.f, gA1 = 0.f, gA2 = 0.f, gA3 = 0.f;
  tA = (u32x4){0u, 0u, 0u, 0u};
#define LN_ISSUE(cc_, K_, V_, T_, G0_, G1_, G2_, G3_) do {                                                                                \
    _Pragma("unroll") for (int i_ = 0; i_ < 2; ++i_) { const int idx_ = tid + 512 * i_, t_ = idx_ >> 4, pc_ = idx_ & 15;                 \
      const size_t R_ = (size_t)b * TOK + row_of(dir, 64 * (cc_) + t_); const bf16_t* rp_ = src + R_ * rstride + pc_ * 8;                   \
      K_[i_] = *(const u32x4*)(rp_ + koff); V_[i_] = *(const u32x4*)(rp_ + voff); }                                                         \
    if (MIX == 2) T_ = *(const u32x4*)(TB + (size_t)(cc_) * 4096 + (tid >> 3) * 64 + (tid & 7) * 8);                                       \
    if (w == 0 && MIX != 1) { const size_t R_ = (size_t)b * TOK + row_of(dir, 64 * (cc_) + lane); const float* gp_ = (const float*)(p.ws + WS_GP) + R_ * GPW; \
      if (MIX == 0) { gp_ += (dir * 4 + h) * 3; G0_ = gp_[0]; G1_ = gp_[1]; G2_ = gp_[2]; }                                                \
      else { const f32x4 q_ = *(const f32x4*)(gp_ + 24 + (dir * 4 + h) * 4); G0_ = q_[0]; G1_ = q_[1]; G2_ = q_[2]; G3_ = q_[3]; } } } while (0)
#define LN_COMMIT(cc_, buf_, K_, V_, T_, G0_, G1_, G2_, G3_) do { unsigned char* lb_ = lds + (buf_) * lean::LB; float* gt_ = (float*)(lds + lean::L_G) + (buf_) * 448; \
    _Pragma("unroll") for (int i_ = 0; i_ < 2; ++i_) { const int idx_ = tid + 512 * i_, t_ = idx_ >> 4, pc_ = idx_ & 15;                 \
      const int po_ = ((pc_ >> 2) * 32 + (pc_ & 1) * 16 + ((pc_ >> 1) & 1) * 4) * 2;                                                          \
      *(unsigned long long*)(lb_ + t_ * KSB + po_) = (unsigned long long)K_[i_][0] | ((unsigned long long)K_[i_][1] << 32); *(unsigned long long*)(lb_ + t_ * KSB + po_ + 16) = (unsigned long long)K_[i_][2] | ((unsigned long long)K_[i_][3] << 32); \
      *(u32x4*)(lb_ + 64 * KSB + t_ * KSB + pc_ * 16) = V_[i_]; }                                                                          \
    if (MIX == 2) *(u32x4*)(lb_ + 128 * KSB + (tid >> 3) * TSB + (tid & 7) * 16) = T_;                                                     \
    if (w == 0) { float alpha_, wv_, beta_ = 0.f, cd_;                                                                                     \
      if (MIX == 0) { if (((cc_) & 7) == 4 && lane == 0) ((float*)(p.ws + WS_CKN))[((size_t)seq * 8 + ((cc_) >> 3)) * 132 + 128] = m_state;  \
        const float run_ = fmaxf(m_state, G1_); const float run63_ = __shfl(run_, 63), bend_ = __shfl(G2_, 63);                               \
        alpha_ = __expf(m_state - run_); wv_ = __expf(G0_ - run63_); cd_ = __expf(m_state - run63_); m_state = bend_ + run63_; }              \
      else if (MIX == 1) { const float lg_ = p.r_lg[gi]; alpha_ = __expf(lg_ * (float)(lane + 1)); wv_ = __expf(lg_ * (float)(63 - lane)); cd_ = __expf(lg_ * 64.f); } \
      else { alpha_ = G1_; wv_ = G2_; beta_ = G3_; cd_ = __shfl(G1_, 63); }                                                                  \
      gt_[128 + lane] = alpha_; gt_[192 + lane] = wv_; gt_[256 + lane] = beta_; if (lane == 0) gt_[384] = cd_; } } while (0)
#define LN_STEP(cc_, buf_) do { const unsigned char* lb_ = lds + (buf_) * lean::LB; const float* gts = (const float*)(lds + lean::L_G) + (buf_) * 448;            \
    if (((cc_) & 7) == 4) { const int ck_ = (cc_) >> 3;                                                                                    \
      unsigned long long* cp_ = (unsigned long long*)(p.ws + WS_CK) + (((size_t)seq * 8 + ck_) * 8 + w) * 8 * 64 + lane;                     \
      _Pragma("unroll") for (int i_ = 0; i_ < 8; ++i_) cp_[i_ * 64] = (unsigned long long)cvtpk(S[i_][0], S[i_][1]) | ((unsigned long long)cvtpk(S[i_][2], S[i_][3]) << 32); \
      if (MIX == 0 && g == 0) ((float*)(p.ws + WS_CKN))[((size_t)seq * 8 + ck_) * 132 + 16 * w + c16] = nreg; }                              \
    const float cd = gts[384]; bf16x8 Wb[2];                                                                                               \
    if (MIX == 2) { bf16x8 Sb[4]; f32x4 KS[4], X[4];                                                                                       \
      _Pragma("unroll") for (int kb = 0; kb < 4; ++kb) Sb[kb] = pack2(S[2 * kb], S[2 * kb + 1]);                                            \
      _Pragma("unroll") for (int tb = 0; tb < 4; ++tb) { KS[tb] = (f32x4){0.f, 0.f, 0.f, 0.f};                                              \
        _Pragma("unroll") for (int kb = 0; kb < 4; ++kb) KS[tb] = MFMA16(ld_perm(lb_ + (16 * tb + c16) * KSB, kb, g), Sb[kb], KS[tb]); }     \
      _Pragma("unroll") for (int tb = 0; tb < 4; ++tb) { const f32x4 al = *(const f32x4*)(gts + 128 + 16 * tb + 4 * g), be = *(const f32x4*)(gts + 256 + 16 * tb + 4 * g); \
        const bf16x4 vv = tr_read(lb_ + 64 * KSB + trb + (16 * tb) * KSB + 32 * w);                                                         \
        _Pragma("unroll") for (int r = 0; r < 4; ++r) KS[tb][r] = be[r] * (bf2f((bf16_t)vv[r]) - al[r] * KS[tb][r]); }                      \
      const bf16x8 Rb0 = pack2(KS[0], KS[1]), Rb1 = pack2(KS[2], KS[3]);                                                                     \
      _Pragma("unroll") for (int tb = 0; tb < 4; ++tb) { X[tb] = (f32x4){0.f, 0.f, 0.f, 0.f};                                               \
        X[tb] = MFMA16(ld_perm(lb_ + 128 * KSB + (16 * tb + c16) * TSB, 0, g), Rb0, X[tb]); X[tb] = MFMA16(ld_perm(lb_ + 128 * KSB + (16 * tb + c16) * TSB, 1, g), Rb1, X[tb]); \
        const f32x4 wv = *(const f32x4*)(gts + 192 + 16 * tb + 4 * g); X[tb] = X[tb] * wv; }                                                \
      Wb[0] = pack2(X[0], X[1]); Wb[1] = pack2(X[2], X[3]);                                                                                  \
    } else {                                                                                                                               \
      _Pragma("unroll") for (int ks = 0; ks < 2; ++ks) { const bf16x8 xb = tr_pair(lb_ + 64 * KSB + trb + (32 * ks) * KSB + 32 * w, 16 * KSB); \
        const f32x4 w0 = *(const f32x4*)(gts + 192 + 32 * ks + 4 * g), w1 = *(const f32x4*)(gts + 192 + 32 * ks + 16 + 4 * g); f32x4 x0, x1;  \
        _Pragma("unroll") for (int j = 0; j < 4; ++j) { x0[j] = bf2f((bf16_t)xb[j]) * w0[j]; x1[j] = bf2f((bf16_t)xb[4 + j]) * w1[j]; }     \
        Wb[ks] = pack2(x0, x1); } }                                                                                                        \
    _Pragma("unroll") for (int hh = 0; hh < 2; ++hh) { bf16x8 kf[8];                                                                       \
      _Pragma("unroll") for (int ii = 0; ii < 4; ++ii) { const int i = 4 * hh + ii; kf[2 * ii] = tr_pair(lb_ + trk + 64 * (i >> 1) + 8 * (i & 1), 16 * KSB); kf[2 * ii + 1] = tr_pair(lb_ + trk + 32 * KSB + 64 * (i >> 1) + 8 * (i & 1), 16 * KSB); S[i] = S[i] * cd; } \
      __builtin_amdgcn_sched_barrier(0);                                                                                                   \
      _Pragma("unroll") for (int ii = 0; ii < 4; ++ii) { const int i = 4 * hh + ii; S[i] = MFMA16(kf[2 * ii], Wb[0], S[i]); S[i] = MFMA16(kf[2 * ii + 1], Wb[1], S[i]); } \
      __builtin_amdgcn_sched_barrier(0); }                                                                                                 \
    if (MIX == 0) { float a = 0.f; const bf16_t* kp = (const bf16_t*)lb_ + (16 * g) * KS_ + pcol(16 * w + c16);                             \
      _Pragma("unroll") for (int k = 0; k < 16; ++k) a += gts[192 + 16 * g + k] * bf2f(kp[k * KS_]);                                        \
      a += __shfl_xor(a, 16); a += __shfl_xor(a, 32); nreg = cd * nreg + a; } } while (0)

  LN_ISSUE(0, kA, vA, tA, gA0, gA1, gA2, gA3);
  LN_COMMIT(0, 0, kA, vA, tA, gA0, gA1, gA2, gA3);
  LN_ISSUE(1, kA, vA, tA, gA0, gA1, gA2, gA3);
  for (int cc = 0; cc < NCH; cc += 2) {
    __syncthreads();
    LN_STEP(cc, 0);
    LN_COMMIT(cc + 1, 1, kA, vA, tA, gA0, gA1, gA2, gA3);
    if (cc + 2 < NCH) LN_ISSUE(cc + 2, kA, vA, tA, gA0, gA1, gA2, gA3);
    __syncthreads();
    LN_STEP(cc + 1, 1);
    if (cc + 2 < NCH) { LN_COMMIT(cc + 2, 0, kA, vA, tA, gA0, gA1, gA2, gA3); if (cc + 3 < NCH) LN_ISSUE(cc + 3, kA, vA, tA, gA0, gA1, gA2, gA3); }
  }
  __syncthreads();
#undef LN_ISSUE
#undef LN_COMMIT
#undef LN_STEP
}

}

namespace pdn {
constexpr int CBS = 520;
constexpr int L_CB = 0, L_KK = 64 * CBS * 2, L_GL = L_KK + 4 * 64 * 64 * 4, L_END = L_GL + 2 * 8 * 64 * 4;
template <int DIR> DI scn::f32x4 ld_l4(const float* kk, const int t, const int q) {
  if (DIR == 0) return *(const scn::f32x4*)(kk + t * 64 + 4 * q);
  const scn::f32x4 v = *(const scn::f32x4*)(kk + (63 - t) * 64 + 60 - 4 * q); return (scn::f32x4){v[3], v[2], v[1], v[0]};
}
template <int DIR> DI void solve_tri(const float* kk, const int lane, float (&Tc)[64]) {
#pragma unroll
  for (int I = 0; I < 4; ++I) {
    float acc[16];
#pragma unroll
    for (int r = 0; r < 16; ++r) acc[r] = (lane == 16 * I + r) ? 1.f : 0.f;
#pragma unroll
    for (int q = 0; q < 4 * I; ++q) {
#pragma unroll
      for (int r = 0; r < 16; ++r) { const scn::f32x4 v = ld_l4<DIR>(kk, 16 * I + r, q); acc[r] -= v[0] * Tc[4 * q]; acc[r] -= v[1] * Tc[4 * q + 1]; acc[r] -= v[2] * Tc[4 * q + 2]; acc[r] -= v[3] * Tc[4 * q + 3]; }
      asm volatile("" ::: "memory"); }
    scn::f32x4 cur[4], nxt[4];
#pragma unroll
    for (int qq = 0; qq < 4; ++qq) { cur[qq] = ld_l4<DIR>(kk, 16 * I, 4 * I + qq); nxt[qq] = cur[qq]; }
#pragma unroll
    for (int r = 0; r < 16; ++r) {
      if (r < 15) {
#pragma unroll
        for (int qq = 0; qq < 4; ++qq) if (4 * qq < r + 1) nxt[qq] = ld_l4<DIR>(kk, 16 * I + r + 1, 4 * I + qq); }
      float a0 = acc[r], a1 = 0.f;
#pragma unroll
      for (int sp = 0; sp < r; ++sp) { const float lv = cur[sp >> 2][sp & 3]; if (sp & 1) a1 -= lv * Tc[16 * I + sp]; else a0 -= lv * Tc[16 * I + sp]; }
      float res = a0 + a1;
      asm volatile("" : "+v"(res) :: "memory");
      Tc[16 * I + r] = res;
#pragma unroll
      for (int qq = 0; qq < 4; ++qq) cur[qq] = nxt[qq];
    }
  }
}
DI void prep_unit(const Params& p, const int layer, const int b, const int cc, const int mode, unsigned char* lds) {
  const int tid = opq_tid(), lane = tid & 63, w = __builtin_amdgcn_readfirstlane(tid >> 6), c16 = lane & 15, g = lane >> 4;
  const bf16_t* U = (const bf16_t*)(p.ws + WS_U); bf16_t* DQ = (bf16_t*)(p.ws + WS_DQ);
  bf16_t* CB = (bf16_t*)(lds + L_CB); float* KK = (float*)(lds + L_KK); float* GL = (float*)(lds + L_GL);
  const size_t R0 = (size_t)b * TOK + 64 * cc; const bool isctx = cc < 4; const int pos0 = isctx ? 64 * cc : 64 * (cc - 4), len = isctx ? CTX : SEQ;
  const float* cw = p.conv_w + (size_t)layer * 5 * 1536;
  {
    const int part = mode == 0 ? 1 : (mode == 1 ? 0 : 2);
    {
      typedef float f32x2 __attribute__((ext_vector_type(2)));
      const int cp = tid & 255, th = tid >> 8, ch = part * 512 + 2 * cp; const bf16_t* up = U + (R0 + 32 * th) * NU + UC_DQ + ch;
      f32x2 cwv[5];
#pragma unroll
      for (int j = 0; j < 5; ++j) { const float2 q = *(const float2*)(cw + j * 1536 + ch); cwv[j] = (f32x2){q.x, q.y}; }
      unsigned xr[36];
#pragma unroll
      for (int i = 0; i < 36; ++i) { const int pp = pos0 + 32 * th - 2 + i; xr[i] = (pp >= 0 && pp < len) ? *(const unsigned*)(up + (ptrdiff_t)(i - 2) * NU) : 0u; }
#pragma unroll
      for (int t = 0; t < 32; ++t) { f32x2 a = (f32x2){0.f, 0.f};
#pragma unroll
        for (int j = 0; j < 5; ++j) { const f32x2 x = (f32x2){__uint_as_float(xr[t + j] << 16), __uint_as_float(xr[t + j] & 0xffff0000u)}; a += x * cwv[j]; }
        *(unsigned*)(CB + (32 * th + t) * CBS + 2 * cp) = scn::cvtpk(siluf(a.x), siluf(a.y)); } }
    __syncthreads();
    { const int t = tid >> 3, p8 = tid & 7;
      scn::u32x4 v[8]; float ss = 0.f;
#pragma unroll
      for (int k = 0; k < 8; ++k) { v[k] = *(const scn::u32x4*)(CB + t * CBS + 64 * p8 + 8 * k);
#pragma unroll
        for (int e = 0; e < 4; ++e) { const float x0 = __uint_as_float(v[k][e] << 16), x1 = __uint_as_float(v[k][e] & 0xffff0000u); ss += x0 * x0 + x1 * x1; } }
      if (part < 2) { ss += __shfl_xor(ss, 1); float rs = rsqrtf(ss + EPS); if (part == 0) rs *= QSCALE;
#pragma unroll
        for (int k = 0; k < 8; ++k)
#pragma unroll
          for (int e = 0; e < 4; ++e) { const float x0 = __uint_as_float(v[k][e] << 16) * rs, x1 = __uint_as_float(v[k][e] & 0xffff0000u) * rs; v[k][e] = scn::cvtpk(x0, x1); } }
      bf16_t* dp = DQ + (R0 + t) * 1536 + part * 512 + 64 * p8;
#pragma unroll
      for (int k = 0; k < 8; ++k) *(scn::u32x4*)(dp + 8 * k) = v[k];
      if (part == 1) {
#pragma unroll
        for (int k = 0; k < 8; ++k) *(scn::u32x4*)(CB + t * CBS + 64 * p8 + 8 * k) = v[k]; } }
    __syncthreads();
  }
  if (mode != 0) return;
  { const int tb = w >> 1;
#pragma unroll
    for (int head = 0; head < 4; ++head)
#pragma unroll
      for (int q2 = 0; q2 < 2; ++q2) { const int sb = 2 * (w & 1) + q2; scn::f32x4 acc = (scn::f32x4){0.f, 0.f, 0.f, 0.f};
#pragma unroll
        for (int kb = 0; kb < 4; ++kb) { const scn::bf16x8 a = *(const scn::bf16x8*)((const unsigned char*)CB + (16 * tb + c16) * (CBS * 2) + head * 256 + kb * 64 + g * 16), bb = *(const scn::bf16x8*)((const unsigned char*)CB + (16 * sb + c16) * (CBS * 2) + head * 256 + kb * 64 + g * 16);
          acc = MFMA16(a, bb, acc); }
#pragma unroll
        for (int r = 0; r < 4; ++r) KK[head * 4096 + (16 * tb + 4 * g + r) * 64 + 16 * sb + c16] = acc[r]; } }
  __syncthreads();
  {
    const int hh = w >> 1, dir = w & 1; const int gi = layer * 8 + dir * 4 + hh;
    float* gl = GL + w * 128; float* bl = gl + 64; float* kk = KK + hh * 4096;
    { const int tt = dir == 0 ? lane : 63 - lane; const bf16_t* up = U + (R0 + tt) * NU + dir * 4 + hh; float* gp = (float*)(p.ws + WS_GP) + (R0 + tt) * GPW;
      const float la = -__expf(p.a_log[gi]) * softplusf(bf2f(up[UC_DA]) + p.dt_bias[gi]); const float gg = scn::wave_psum(la, lane); const float bt = sigmoidf(bf2f(up[UC_DB])); const float g63 = __shfl(gg, 63);
      gl[lane] = gg; bl[lane] = bt;
      *(scn::f32x4*)(gp + 24 + (dir * 4 + hh) * 4) = (scn::f32x4){gg, __expf(gg), __expf(g63 - gg), bt};
      const float li = bf2f(up[UC_MI]) + p.m_ib[gi], lf = logsigmoidf(bf2f(up[UC_MF]) + p.m_fb[gi]); const float bc = scn::wave_psum(lf, lane); const float a = li - bc; const float cm = scn::wave_pmax(a, lane);
      float* gm = gp + (dir * 4 + hh) * 3; gm[0] = a; gm[1] = cm; gm[2] = bc; }
    { const float gs = gl[lane];
#pragma unroll
      for (int t0 = 0; t0 < 64; t0 += 16) { float kv[16];
#pragma unroll
        for (int r = 0; r < 16; ++r) { const int t = t0 + r; kv[r] = kk[dir == 0 ? t * 64 + lane : (63 - t) * 64 + 63 - lane]; }
#pragma unroll
        for (int r = 0; r < 16; ++r) { const int t = t0 + r; kv[r] = bl[t] * __expf(gl[t] - gs) * kv[r]; }
#pragma unroll
        for (int r = 0; r < 16; ++r) { const int t = t0 + r; if (t > 0 && lane < t) kk[dir == 0 ? t * 64 + lane : (63 - t) * 64 + 63 - lane] = kv[r]; }
        asm volatile("" ::: "memory"); } }
    float Tc[64];
    if (dir == 0) solve_tri<0>(kk, lane, Tc); else solve_tri<1>(kk, lane, Tc);
    const int cscan = dir == 0 ? cc : (isctx ? 3 - cc : 71 - cc);
    bf16_t* tb = (bf16_t*)(p.ws + WS_TB) + ((size_t)((b * NH + hh) * 2 + dir) * scn::NCH + cscan) * 4096;
#pragma unroll
    for (int t = 0; t < 64; ++t) tb[t * 64 + scn::pcol(lane)] = f2bf(Tc[t]);
  }
  __syncthreads();
}
}
constexpr int LDS_CTL = 136192;
static_assert(pdn::L_END <= LDS_CTL && scn::L_END <= LDS_CTL && scn::lean::L_END <= LDS_CTL && pg8::STAGE_BYTES <= LDS_CTL, "LDS map");


namespace attn {
using bf16 = unsigned short;
constexpr int   D = 128, NW = 8, QBLK = 32, KVBLK = 64;
constexpr float SCALE = 0.088388347648318440f;
constexpr float THR = 8.f;
constexpr int SDEPTH = 2;
constexpr int LDQ = NU, LDK = NU, LDZ = NU, LDO = DM;
constexpr size_t SHM_V = KVBLK * D * 2, SHM_K = KVBLK * D * 2, SHM_ATTN = 2 * SHM_V + 2 * SHM_K + NW * 64 * 4;
using bf16x8 = __attribute__((ext_vector_type(8))) short;
using s16x4  = __attribute__((ext_vector_type(4))) short;
using f32x16 = __attribute__((ext_vector_type(16))) float;
using f32x8  = __attribute__((ext_vector_type(8))) float;
using u32x4  = __attribute__((ext_vector_type(4))) unsigned;
#define KSWZ(row, colB) ((row) * 256 + ((colB) ^ (((row) & 7) << 4)))
#define SBAR() __builtin_amdgcn_sched_barrier(0)
__device__ __forceinline__ int crow(int r, int hi) { return (r & 3) + 8 * (r >> 2) + 4 * hi; }
__device__ __forceinline__ unsigned cvtpk(float lo, float hi) {
  unsigned r; asm volatile("v_cvt_pk_bf16_f32 %0, %1, %2" : "=v"(r) : "v"(lo), "v"(hi)); return r;
}
template <typename TIn> struct Stage;
template <> struct Stage<bf16>  { using T = bf16x8;
  __device__ static __forceinline__ T ld8(const bf16* p) { return *reinterpret_cast<const bf16x8*>(p); }
  __device__ static __forceinline__ bf16x8 tobf(T x) { return x; } };
template <> struct Stage<float> { using T = f32x8;
  __device__ static __forceinline__ T ld8(const float* p) { return *reinterpret_cast<const f32x8*>(p); }
  __device__ static __forceinline__ bf16x8 tobf(T x) {
    u32x4 w = {cvtpk(x[0], x[1]), cvtpk(x[2], x[3]), cvtpk(x[4], x[5]), cvtpk(x[6], x[7])}; return *reinterpret_cast<bf16x8*>(&w); } };

__device__ __forceinline__ void partialSM(f32x16& p0, f32x16& p1, float& m_reg, float& mn, float& alpha) {
  constexpr float C = SCALE * 1.4426950408889634f;
  float pmax = p0[0]; for (int r = 1; r < 16; ++r) pmax = fmaxf(pmax, p0[r]); for (int r = 0; r < 16; ++r) pmax = fmaxf(pmax, p1[r]);
  { auto rr = __builtin_amdgcn_permlane32_swap(__float_as_uint(pmax), __float_as_uint(pmax), false, false);
    pmax = fmaxf(__uint_as_float(rr[0]), __uint_as_float(rr[1])); }
  if (__builtin_expect(__all(pmax - m_reg <= THR / SCALE), 1)) { mn = m_reg; alpha = 1.f; }
  else { mn = fmaxf(m_reg, pmax); alpha = __builtin_amdgcn_exp2f((m_reg - mn) * C); m_reg = mn; }
  float mnC = -mn * C;
  for (int r = 0; r < 16; ++r) p0[r] = fmaf(p0[r], C, mnC); for (int r = 0; r < 16; ++r) p1[r] = fmaf(p1[r], C, mnC);
  for (int r = 0; r < 16; ++r) p0[r] = __builtin_amdgcn_exp2f(p0[r]);
}
__device__ __forceinline__ void finishSM(f32x16& p0, f32x16& p1, float alpha, float& l_reg, bf16x8& pa0, bf16x8& pa1, bf16x8& pa2, bf16x8& pa3) {
  for (int r = 0; r < 16; ++r) p1[r] = __builtin_amdgcn_exp2f(p1[r]);
  float ps = 0; for (int r = 0; r < 16; ++r) ps += p0[r]; for (int r = 0; r < 16; ++r) ps += p1[r];
  { auto rr = __builtin_amdgcn_permlane32_swap(__float_as_uint(ps), __float_as_uint(ps), false, false);
    ps = __uint_as_float(rr[0]) + __uint_as_float(rr[1]); }
  l_reg = l_reg * alpha + ps;
#define PK4(P, BASE, OUT) do { unsigned a0 = cvtpk(P[BASE + 0], P[BASE + 1]), a1 = cvtpk(P[BASE + 2], P[BASE + 3]);   \
    unsigned b0 = cvtpk(P[BASE + 4], P[BASE + 5]), b1 = cvtpk(P[BASE + 6], P[BASE + 7]);                              \
    auto r0 = __builtin_amdgcn_permlane32_swap(a0, b0, false, false); auto r1 = __builtin_amdgcn_permlane32_swap(a1, b1, false, false); \
    u32x4 w = {r0[0], r1[0], r0[1], r1[1]}; OUT = *reinterpret_cast<bf16x8*>(&w); } while (0)
  PK4(p0, 0, pa0); PK4(p0, 8, pa1); PK4(p1, 0, pa2); PK4(p1, 8, pa3);
#undef PK4
}
__device__ __forceinline__ void qkt(f32x16& p0, f32x16& p1, const bf16* Ks, const bf16x8* qr, int r32, int hi) {
  p0 = f32x16{}; p1 = f32x16{};
  for (int d0 = 0; d0 < 8; ++d0) { int cb = (d0 * 16 + hi * 8) * 2;
    bf16x8 b0 = *reinterpret_cast<const bf16x8*>((const char*)Ks + KSWZ(r32, cb));
    bf16x8 b1 = *reinterpret_cast<const bf16x8*>((const char*)Ks + KSWZ(32 + r32, cb));
    p0 = __builtin_amdgcn_mfma_f32_32x32x16_bf16(b0, qr[d0], p0, 0, 0, 0);
    p1 = __builtin_amdgcn_mfma_f32_32x32x16_bf16(b1, qr[d0], p1, 0, 0, 0); }
}
__device__ __forceinline__ int v_st(int k, int c) { const int kk = (k & ~0xC) | ((k & 4) << 1) | ((k & 8) >> 1); return ((kk >> 3) * 4 + (c >> 5)) * 512 + ((kk & 7) * 32 + (c & 31)) * 2; }
__device__ __forceinline__ int v_rd_base(int lane) { return ((lane & 3) << 3) | (((lane >> 2) & 3) << 6) | (((lane >> 4) & 1) << 5) | (((lane >> 5) & 1) << 8); }
constexpr int v_rd_off(int d0, int ks, int half) { return d0 * 512 + ks * 4096 + half * 2048; }
template <int OFF> __device__ __forceinline__ s16x4 tr_read(int vb) {
  s16x4 r; asm volatile("ds_read_b64_tr_b16 %0, %1 offset:%2" : "=&v"(r) : "v"(vb), "i"(OFF) : "memory"); return r;
}
template <int D0> __device__ __forceinline__ void pv_one(f32x16& od, int vb, bf16x8 pa0, bf16x8 pa1, bf16x8 pa2, bf16x8 pa3) {
  const s16x4 l0 = tr_read<v_rd_off(D0, 0, 0)>(vb), h0 = tr_read<v_rd_off(D0, 0, 1)>(vb), l1 = tr_read<v_rd_off(D0, 1, 0)>(vb), h1 = tr_read<v_rd_off(D0, 1, 1)>(vb);
  const s16x4 l2 = tr_read<v_rd_off(D0, 2, 0)>(vb), h2 = tr_read<v_rd_off(D0, 2, 1)>(vb), l3 = tr_read<v_rd_off(D0, 3, 0)>(vb), h3 = tr_read<v_rd_off(D0, 3, 1)>(vb);
  asm volatile("s_waitcnt lgkmcnt(0)" ::: "memory"); SBAR();
#define PK(L, H) (bf16x8){L[0], L[1], L[2], L[3], H[0], H[1], H[2], H[3]}
  od = __builtin_amdgcn_mfma_f32_32x32x16_bf16(pa0, PK(l0, h0), od, 0, 0, 0);
  od = __builtin_amdgcn_mfma_f32_32x32x16_bf16(pa1, PK(l1, h1), od, 0, 0, 0);
  od = __builtin_amdgcn_mfma_f32_32x32x16_bf16(pa2, PK(l2, h2), od, 0, 0, 0);
  od = __builtin_amdgcn_mfma_f32_32x32x16_bf16(pa3, PK(l3, h3), od, 0, 0, 0);
#undef PK
}
__device__ __forceinline__ void pv_d0(f32x16* o, int vb, bf16x8 pa0, bf16x8 pa1, bf16x8 pa2, bf16x8 pa3) {
  pv_one<0>(o[0], vb, pa0, pa1, pa2, pa3); pv_one<1>(o[1], vb, pa0, pa1, pa2, pa3); pv_one<2>(o[2], vb, pa0, pa1, pa2, pa3); pv_one<3>(o[3], vb, pa0, pa1, pa2, pa3);
}
template <typename TQ>
__device__ __forceinline__ void attn_dense_body(const TQ* __restrict__ Qb, const bf16* __restrict__ Kh, const bf16* __restrict__ Vh,
                                                const bf16* __restrict__ Zb, bf16* __restrict__ Ob, int seq, char* lds) {
  using St = Stage<bf16>; using SQ = Stage<TQ>;
  const int tid = opq_tid(), wid = __builtin_amdgcn_readfirstlane(tid >> 6), lane = tid & 63, r32 = lane & 31, hi = lane >> 5;
  bf16* V_lds = (bf16*)lds; bf16* K_lds = (bf16*)(lds + 2 * SHM_V);
  float* ws = (float*)(lds + 2 * SHM_V + 2 * SHM_K) + wid * 64; float* li_l = ws; float* al_l = ws + 32;
  float m_reg = -1e30f, l_reg = 0; f32x16 o[4] = {}; bf16x8 qr[8];
  const TQ* Qw = Qb + (long)(wid * QBLK + r32) * LDQ + hi * 8;
#pragma unroll
  for (int d0 = 0; d0 < 8; ++d0) qr[d0] = SQ::tobf(SQ::ld8(Qw + d0 * 16));
  const int sr = tid >> 4, sc = (tid & 15) * 8, vst0 = v_st(sr, sc), vst1 = v_st(32 + sr, sc);
  const int vb0 = (int)(uintptr_t)V_lds + v_rd_base(lane);
  struct { typename St::T vs0, vs1, ks0, ks1; } sr_[SDEPTH];
#define SLOAD(i, k0) do { sr_[i].vs0 = St::ld8(&Vh[(long)((k0) + sr) * LDK + sc]); sr_[i].vs1 = St::ld8(&Vh[(long)((k0) + 32 + sr) * LDK + sc]); \
    sr_[i].ks0 = St::ld8(&Kh[(long)((k0) + sr) * LDK + sc]); sr_[i].ks1 = St::ld8(&Kh[(long)((k0) + 32 + sr) * LDK + sc]); } while (0)
#define SWRITE(b, i) do { *(bf16x8*)((char*)V_lds + (b) * SHM_V + vst0) = St::tobf(sr_[i].vs0);          \
    *(bf16x8*)((char*)V_lds + (b) * SHM_V + vst1) = St::tobf(sr_[i].vs1); int kc = sc * 2;               \
    *(bf16x8*)((char*)K_lds + (b) * SHM_K + KSWZ(sr, kc)) = St::tobf(sr_[i].ks0);                       \
    *(bf16x8*)((char*)K_lds + (b) * SHM_K + KSWZ(32 + sr, kc)) = St::tobf(sr_[i].ks1); } while (0)
#define SWAIT() do { if constexpr (SDEPTH == 2) asm volatile("s_waitcnt vmcnt(4)" ::: "memory"); else asm volatile("s_waitcnt vmcnt(0)" ::: "memory"); } while (0)
#define RESC(a) do { if (__any((a) < 1.f)) { if (hi == 0) al_l[r32] = (a); asm volatile("s_waitcnt lgkmcnt(0)" ::: "memory"); \
    for (int d = 0; d < 4; ++d) for (int r = 0; r < 16; ++r) o[d][r] *= al_l[crow(r, hi)]; } } while (0)
  f32x16 pA0, pA1, pB0, pB1; float mnA, mnB, alA, alB; bf16x8 pa0, pa1, pa2, pa3; const int NT = seq / KVBLK;
  constexpr int SE = 0, SO = SDEPTH - 1;
  SLOAD(SE, 0); asm volatile("s_waitcnt vmcnt(0)" ::: "memory"); SWRITE(0, SE); __syncthreads();
  qkt(pA0, pA1, K_lds, qr, r32, hi); partialSM(pA0, pA1, m_reg, mnA, alA);
  SLOAD(SO, KVBLK); if constexpr (SDEPTH == 2) { if (2 < NT) SLOAD(SE, 2 * KVBLK); }
  SWAIT(); SWRITE(1, SO); __syncthreads();
  for (int j = 1; j + 1 < NT; j += 2) {
    SBAR(); qkt(pB0, pB1, (bf16*)((char*)K_lds + SHM_K), qr, r32, hi);
    finishSM(pA0, pA1, alA, l_reg, pa0, pa1, pa2, pa3); SBAR();
    SLOAD(SO, (j + SDEPTH) * KVBLK); SBAR();
    pv_d0(o, vb0, pa0, pa1, pa2, pa3); partialSM(pB0, pB1, m_reg, mnB, alB);
    __syncthreads(); SWAIT(); SWRITE(0, SE);
    RESC(alB); __syncthreads();
    SBAR(); qkt(pA0, pA1, K_lds, qr, r32, hi);
    finishSM(pB0, pB1, alB, l_reg, pa0, pa1, pa2, pa3); SBAR();
    if (SDEPTH == 1 || j + 3 < NT) SLOAD(SE, (j + 1 + SDEPTH) * KVBLK); SBAR();
    pv_d0(o, vb0 + (int)SHM_V, pa0, pa1, pa2, pa3); partialSM(pA0, pA1, m_reg, mnA, alA);
    __syncthreads(); SWAIT(); SWRITE(1, SO);
    RESC(alA); __syncthreads();
  }
  SBAR(); qkt(pB0, pB1, (bf16*)((char*)K_lds + SHM_K), qr, r32, hi);
  finishSM(pA0, pA1, alA, l_reg, pa0, pa1, pa2, pa3); SBAR();
  pv_d0(o, vb0, pa0, pa1, pa2, pa3); partialSM(pB0, pB1, m_reg, mnB, alB);
  __syncthreads(); RESC(alB);
  finishSM(pB0, pB1, alB, l_reg, pa0, pa1, pa2, pa3); SBAR();
  pv_d0(o, vb0 + (int)SHM_V, pa0, pa1, pa2, pa3);
  if (hi == 0) li_l[r32] = l_reg; asm volatile("s_waitcnt lgkmcnt(0)" ::: "memory");
  float rli[16];
#pragma unroll
  for (int r = 0; r < 16; ++r) rli[r] = __builtin_amdgcn_rcpf(li_l[crow(r, hi)]);
  __syncthreads();
  asm volatile("" ::: "memory");
  { bf16* stg = (bf16*)lds + wid * (QBLK * D);
#pragma unroll
    for (int r = 0; r < 16; ++r) { const int orow = crow(r, hi);
#pragma unroll
      for (int d0 = 0; d0 < 4; ++d0) stg[orow * D + d0 * 32 + r32] = f2bf(o[d0][r] * rli[r]); }
    asm volatile("s_waitcnt lgkmcnt(0)" ::: "memory");
    bf16* Ow = Ob + (long)(wid * QBLK) * LDO; const bf16* Zw = Zb + (long)(wid * QBLK) * LDZ;
    int ln = lane; asm volatile("" : "+v"(ln));
#pragma unroll
    for (int i = 0; i < 8; ++i) { const int row = i * 4 + (ln >> 4), ch = ln & 15;
      const u32x4 ov = *(const u32x4*)(stg + row * D + ch * 8); const u32x4 zv = *(const u32x4*)(Zw + (long)row * LDZ + ch * 8); u32x4 w;
#pragma unroll
      for (int j = 0; j < 4; ++j) { const float z0 = __uint_as_float(zv[j] << 16), z1 = __uint_as_float(zv[j] & 0xffff0000u), a0 = __uint_as_float(ov[j] << 16), a1 = __uint_as_float(ov[j] & 0xffff0000u);
        w[j] = cvtpk(a0 * z0, a1 * z1); }
      *(u32x4*)(Ow + (long)row * LDO + ch * 8) = w; } }
  __syncthreads();
#undef SLOAD
#undef SWRITE
#undef SWAIT
#undef RESC
}

}

__device__ __forceinline__ void attn_unit(const Params& p, int u, char* lds) {
  const bf16_t* U = (const bf16_t*)(p.ws + WS_U); bf16_t* MG = (bf16_t*)(p.ws + WS_HB);
  int b, h, t0, seq;
  if (u < 256) { b = u >> 6; h = (u >> 4) & 3; t0 = CTX + (u & 15) * 256; seq = TOK; } else { b = (u - 256) >> 2; h = (u - 256) & 3; t0 = 0; seq = CTX; }
  const size_t R0 = (size_t)b * TOK + t0, K0 = (size_t)b * TOK; const int kvh = h >> 1;
  attn::attn_dense_body<attn::bf16>(U + R0 * NU + UC_AQ + h * HD, U + K0 * NU + UC_AK + kvh * HD, U + K0 * NU + UC_AV + kvh * HD, U + R0 * NU + UC_AZ + h * HD, MG + R0 * DM + MG_A + h * HD, seq, lds);
}

#define LAS __attribute__((address_space(3)))
#define XB_TMO      128
#define XB_XCNT(j)  (256  + 64 * (j))
#define XB_XSUB(j)  (1280 + 64 * (j))
#define XB_XGEN(j)  (2304 + 64 * (j))
#define XB_TOP      3328
#define XB_TOPGEN   3392
#define XCD_BAR_WORDS 3456
#define XB_SPIN_CAP (1u << 18)

__device__ __forceinline__ unsigned xb_ld(unsigned* p)              { return __hip_atomic_load(p, __ATOMIC_RELAXED, __HIP_MEMORY_SCOPE_AGENT); }
__device__ __forceinline__ unsigned xb_add(unsigned* p, unsigned v) { return __hip_atomic_fetch_add(p, v, __ATOMIC_RELAXED, __HIP_MEMORY_SCOPE_AGENT); }
__device__ __forceinline__ unsigned xb_xcc_id() { return (unsigned)__builtin_amdgcn_s_getreg((3 << 11) | 20) & 0xFu; }
#define XB_SPIN(cond, bar) do { unsigned _sp = 0; while (cond) { __builtin_amdgcn_s_sleep(1); \
    if ((++_sp & 255u) == 0u) { if (xb_ld(&(bar)[XB_TMO])) break; if (_sp > XB_SPIN_CAP) { atomicAdd(&(bar)[XB_TMO], 1u); break; } } } } while (0)

struct XcdBarrier {
    unsigned* bar; unsigned x;
    volatile LAS unsigned* st;
};

__device__ __forceinline__ XcdBarrier xcd_barrier_post(unsigned* bar, volatile LAS unsigned* st) {
    XcdBarrier b; b.bar = bar; b.x = xb_xcc_id(); b.st = st;
    if (opq_tid() == 0) (void)xb_add(&bar[XB_XCNT(b.x)], 1u);
    return b;
}
__device__ __forceinline__ void xcd_barrier_complete(unsigned* bar, unsigned x, unsigned& nloc, unsigned& nx) {
    const unsigned G = gridDim.x * gridDim.y * gridDim.z;
    unsigned sum, cnt, mine, sp = 0u;
    for (;;) {
        sum = 0u; cnt = 0u; mine = 0u;
#pragma unroll
        for (unsigned j = 0; j < 16; ++j) { const unsigned c = xb_ld(&bar[XB_XCNT(j)]); sum += c; cnt += (c > 0u) ? 1u : 0u; mine = (j == x) ? c : mine; }
        if (sum == G) break;
        __builtin_amdgcn_s_sleep(1);
        if ((++sp & 255u) == 0u) { if (xb_ld(&bar[XB_TMO])) break; if (sp > XB_SPIN_CAP) { atomicAdd(&bar[XB_TMO], 1u); break; } }
    }
    nloc = mine > 0u ? mine : 1u; nx = cnt > 0u ? cnt : 1u;
}

__device__ __forceinline__ void xcd_barrier(const XcdBarrier& b) {
    asm volatile("s_waitcnt vmcnt(0)" ::: "memory");
    __syncthreads();
    if (opq_tid() == 0) {
        unsigned* bar = b.bar;
        __builtin_amdgcn_s_waitcnt(0);
        unsigned nloc = b.st[0], nx = b.st[1];
        if (nloc == 0u) { xcd_barrier_complete(bar, b.x, nloc, nx); b.st[0] = nloc; b.st[1] = nx; }
        const unsigned old = xb_add(&bar[XB_XSUB(b.x)], 1u);
        const unsigned gen = old / nloc;
        if (old + 1u == (gen + 1u) * nloc) {
            __builtin_amdgcn_fence(__ATOMIC_RELEASE, "agent");
            asm volatile("s_waitcnt vmcnt(0)" ::: "memory");
            const unsigned og = xb_add(&bar[XB_TOP], 1u);
            const unsigned tg = og / nx;
            if (og + 1u == (tg + 1u) * nx) xb_add(&bar[XB_TOPGEN], 1u);
            else XB_SPIN(xb_ld(&bar[XB_TOPGEN]) == tg, bar);
            __builtin_amdgcn_fence(__ATOMIC_ACQUIRE, "agent");
            xb_add(&bar[XB_XGEN(b.x)], 1u);
            asm volatile("s_waitcnt vmcnt(0)" ::: "memory");
        } else {
            XB_SPIN(xb_ld(&bar[XB_XGEN(b.x)]) == gen, bar);
            __builtin_amdgcn_fence(__ATOMIC_ACQUIRE, "agent");
            asm volatile("s_waitcnt vmcnt(0)" ::: "memory");
        }
    }
    __syncthreads();
}

namespace mk {
DI void phase_convert(const Params& p, unsigned char* lds, const int layer, const int me_ = -1, const int nw_ = 0) {
  const int half = opq_tid() >> 8, t256 = opq_tid() & 255;
  float* tile = (float*)lds + half * (64 * 65);
  constexpr int n_in_items = (NU / 64) * (DM / 64), n_out_items = 2 * (DM / 64) * (DM / 64);
  const int n_items = n_in_items + (layer == 0 ? n_out_items : 0);
  const int nw = nw_ > 0 ? nw_ : (int)gridDim.x; const int me = me_ >= 0 ? me_ : (int)blockIdx.x;
  for (int it0 = me * 2; it0 < n_items; it0 += nw * 2) {
    const int it = it0 + half;
    const float* W = nullptr; bf16_t* WT = nullptr; int nsrc = 0, n0 = 0, k0 = 0, is_in = 0;
    if (it < n_items) {
      if (it < n_in_items) { n0 = (it / (DM / 64)) * 64; k0 = (it % (DM / 64)) * 64;
        W = p.w_in + (size_t)layer * DM * NIN; WT = (bf16_t*)(p.ws + WS_WIN); nsrc = NIN; is_in = 1; }
      else { const int r0 = it - n_in_items; const int l = r0 / (32 * 32), r = r0 % (32 * 32); n0 = (r / 32) * 64; k0 = (r % 32) * 64;
        W = p.w_out + (size_t)l * DM * DM; WT = (bf16_t*)(p.ws + WS_WOUT) + (size_t)l * DM * DM; nsrc = DM; is_in = 0; }
      const int n = n0 + (t256 & 15) * 4; const int sc = is_in ? ucol_src(n) : n;
      float4 v[4];
#pragma unroll
      for (int i = 0; i < 4; ++i) { const int kk = (t256 >> 4) + 16 * i; v[i] = sc >= 0 ? *(const float4*)(W + (size_t)(k0 + kk) * nsrc + sc) : make_float4(0.f, 0.f, 0.f, 0.f); }
#pragma unroll
      for (int i = 0; i < 4; ++i) { const int kk = (t256 >> 4) + 16 * i; float* tp = tile + kk * 65 + (t256 & 15) * 4; tp[0] = v[i].x; tp[1] = v[i].y; tp[2] = v[i].z; tp[3] = v[i].w; }
    }
    __syncthreads();
    if (it < n_items) {
      const int nn = t256 >> 2, kc = (t256 & 3) * 16; unsigned wv[8];
#pragma unroll
      for (int j = 0; j < 8; ++j) wv[j] = (unsigned)f2bf(tile[(kc + 2 * j) * 65 + nn]) | ((unsigned)f2bf(tile[(kc + 2 * j + 1) * 65 + nn]) << 16);
      uint4* dst = (uint4*)(WT + (size_t)(n0 + nn) * DM + k0 + kc);
      dst[0] = make_uint4(wv[0], wv[1], wv[2], wv[3]); dst[1] = make_uint4(wv[4], wv[5], wv[6], wv[7]);
    }
    __syncthreads();
  }
}
DI void phase_mod(const Params& p, unsigned char* lds) {
  const int tid = opq_tid(), lane = tid & 63, w = tid >> 6;
  float* sv = (float*)lds;
  float* red = sv + 5 * DM;
  bool loaded = false;
  for (int u = blockIdx.x; u < 2 * (3 * DM / 64); u += gridDim.x) {
    if (!loaded) { for (int i = tid; i < 5 * DM; i += 512) { const int r = i / DM, k = i % DM; const float v = r < 4 ? p.c[r * DM + k] : p.c_ctx[k]; sv[i] = siluf(v); } loaded = true; __syncthreads(); }
    const int l = u / (3 * DM / 64), n = (u % (3 * DM / 64)) * 64 + lane;
    const float* W = p.ada_w + (size_t)l * DM * 3 * DM + (size_t)(256 * w) * 3 * DM + n;
    float a0 = 0, a1 = 0, a2 = 0, a3 = 0, a4 = 0;
#pragma unroll 8
    for (int k = 0; k < 256; ++k) { const float wv = W[(size_t)k * 3 * DM]; const int kk = 256 * w + k; a0 += sv[kk] * wv; a1 += sv[DM + kk] * wv; a2 += sv[2 * DM + kk] * wv; a3 += sv[3 * DM + kk] * wv; a4 += sv[4 * DM + kk] * wv; }
    red[(w * 5 + 0) * 64 + lane] = a0; red[(w * 5 + 1) * 64 + lane] = a1; red[(w * 5 + 2) * 64 + lane] = a2; red[(w * 5 + 3) * 64 + lane] = a3; red[(w * 5 + 4) * 64 + lane] = a4;
    __syncthreads();
    if (tid < 320) { const int r = tid >> 6; float s = 0.f;
#pragma unroll
      for (int ww = 0; ww < 8; ++ww) s += red[(ww * 5 + r) * 64 + lane];
      ((float*)(p.ws + WS_MOD))[(size_t)l * 5 * 3 * DM + (size_t)r * 3 * DM + n] = s + p.ada_b[l * 3 * DM + n]; }
    __syncthreads();
  }
}
DI void phase_rope(const Params& p) {
  if (blockIdx.x != gridDim.x - 1 || opq_tid() >= 32) return;
  const int f = opq_tid();
  float* ct = (float*)(p.ws + WS_ROPE); float* st = ct + 64 * 32;
  double th = 1.0; for (int i = 0; i < f; ++i) th *= 0.749894209332456;
  double sn = 0, cs = 0, term = 1.0;
  for (int n = 0; n < 24; ++n) { if ((n & 1) == 0) cs += ((n >> 1) & 1) ? -term : term; else sn += ((n >> 1) & 1) ? -term : term; term *= th / (double)(n + 1); }
  double c = 1.0, s = 0.0;
  for (int pos = 0; pos < 64; ++pos) { ct[pos * 32 + f] = (float)c; st[pos * 32 + f] = (float)s; const double c2 = c * cs - s * sn, s2 = s * cs + c * sn; c = c2; s = s2; }
}
DI void phase_rows(const Params& p, const int lpost, const int lpre, unsigned char* lds) {
  const int tid = opq_tid(), lane = tid & 63, wv = tid >> 6;
  const int RPW = (MROWS + (int)gridDim.x - 1) / (int)gridDim.x; const int r_begin = blockIdx.x * RPW, r_end = (r_begin + RPW < MROWS) ? r_begin + RPW : MROWS;
  if (r_begin >= MROWS) return;
  const int b0 = r_begin / TOK;
  float* V = (float*)lds;
  { const float* modp = lpost >= 0 ? (const float*)(p.ws + WS_MOD) + (size_t)lpost * 5 * 3 * DM : nullptr; const float* modq = lpre >= 0 ? (const float*)(p.ws + WS_MOD) + (size_t)lpre * 5 * 3 * DM : nullptr;
    for (int i = tid; i < DM; i += 512) {
      if (lpost >= 0) { V[i] = p.post_w[lpost * DM + i]; V[DM + i] = modp[(size_t)4 * 3 * DM + 2 * DM + i]; V[2 * DM + i] = modp[(size_t)b0 * 3 * DM + 2 * DM + i]; }
      if (lpre >= 0) { V[3 * DM + i] = p.pre_w[lpre * DM + i]; V[4 * DM + i] = modq[(size_t)4 * 3 * DM + DM + i]; V[5 * DM + i] = modq[(size_t)b0 * 3 * DM + DM + i]; V[6 * DM + i] = modq[(size_t)4 * 3 * DM + i]; V[7 * DM + i] = modq[(size_t)b0 * 3 * DM + i]; } } }
  __syncthreads();
  const bool from_in = lpost <= 0;
#define ROW_SRC(R_, src_) do { const int b_ = (R_) / TOK, t_ = (R_) % TOK; if (t_ < CTX) src_ = (from_in ? p.ctx : (const float*)(p.ws + WS_XC)) + (size_t)(b_ * CTX + t_) * DM; \
    else src_ = (from_in ? p.x : p.out) + (size_t)(b_ * SEQ + (t_ - CTX)) * DM; } while (0)
  float4 xn[8]; ushort4 yn[8];
  int R = r_begin + wv;
  while (R < r_end && (R % TOK) < CTX && lpre < 0) R += 8;
  if (R < r_end) { const float* src; ROW_SRC(R, src);
#pragma unroll
    for (int i = 0; i < 8; ++i) xn[i] = *(const float4*)(src + i * 256 + lane * 4);
    if (lpost >= 0) { const bf16_t* Y = (R % TOK) < CTX ? (const bf16_t*)(p.ws + WS_YC) + (size_t)((R / TOK) * CTX + (R % TOK)) * DM : (const bf16_t*)(p.ws + WS_U) + (size_t)R * DM;
#pragma unroll
      for (int i = 0; i < 8; ++i) yn[i] = *(const ushort4*)(Y + i * 256 + lane * 4); } }
  while (R < r_end) {
    const int b = R / TOK, t = R % TOK; const bool isctx = t < CTX;
    float v[32]; float y[32];
#pragma unroll
    for (int i = 0; i < 8; ++i) { v[4 * i] = xn[i].x; v[4 * i + 1] = xn[i].y; v[4 * i + 2] = xn[i].z; v[4 * i + 3] = xn[i].w; y[4 * i] = bf2f(yn[i].x); y[4 * i + 1] = bf2f(yn[i].y); y[4 * i + 2] = bf2f(yn[i].z); y[4 * i + 3] = bf2f(yn[i].w); }
    int Rn = R + 8; while (Rn < r_end && (Rn % TOK) < CTX && lpre < 0) Rn += 8;
    if (Rn < r_end) { const float* src; ROW_SRC(Rn, src);
#pragma unroll
      for (int i = 0; i < 8; ++i) xn[i] = *(const float4*)(src + i * 256 + lane * 4);
      if (lpost >= 0) { const bf16_t* Y = (Rn % TOK) < CTX ? (const bf16_t*)(p.ws + WS_YC) + (size_t)((Rn / TOK) * CTX + (Rn % TOK)) * DM : (const bf16_t*)(p.ws + WS_U) + (size_t)Rn * DM;
#pragma unroll
        for (int i = 0; i < 8; ++i) yn[i] = *(const ushort4*)(Y + i * 256 + lane * 4); } }
    float* dst = isctx ? (float*)(p.ws + WS_XC) + (size_t)(b * CTX + t) * DM : p.out + (size_t)(b * SEQ + (t - CTX)) * DM;
    const bool inl = (b == b0);
    if (lpost >= 0) {
      float ss = 0.f;
#pragma unroll
      for (int i = 0; i < 32; ++i) ss += y[i] * y[i];
      ss = wave_sum(ss); const float rs = rsqrtf(ss * (1.f / DM) + EPS);
      const float* gv = isctx ? V + DM : V + 2 * DM; const float* gg = (const float*)(p.ws + WS_MOD) + (size_t)lpost * 5 * 3 * DM + (size_t)b * 3 * DM + 2 * DM;
#pragma unroll
      for (int i = 0; i < 8; ++i) { const int c0 = i * 256 + lane * 4; const float4 gq = (isctx || inl) ? *(const float4*)(gv + c0) : *(const float4*)(gg + c0), pq = *(const float4*)(V + c0);
        v[4 * i] += gq.x * y[4 * i] * rs * pq.x; v[4 * i + 1] += gq.y * y[4 * i + 1] * rs * pq.y; v[4 * i + 2] += gq.z * y[4 * i + 2] * rs * pq.z; v[4 * i + 3] += gq.w * y[4 * i + 3] * rs * pq.w;
        float4 o; o.x = v[4 * i]; o.y = v[4 * i + 1]; o.z = v[4 * i + 2]; o.w = v[4 * i + 3]; *(float4*)(dst + c0) = o; }
    }
    if (lpre >= 0) {
      float ss = 0.f;
#pragma unroll
      for (int i = 0; i < 32; ++i) ss += v[i] * v[i];
      ss = wave_sum(ss); const float rs = rsqrtf(ss * (1.f / DM) + EPS);
      bf16_t* hb = (bf16_t*)(p.ws + WS_HB) + (size_t)R * DM;
      const float* scv = isctx ? V + 4 * DM : V + 5 * DM; const float* shv = isctx ? V + 6 * DM : V + 7 * DM; const float* mg = (const float*)(p.ws + WS_MOD) + (size_t)lpre * 5 * 3 * DM + (size_t)b * 3 * DM;
#pragma unroll
      for (int i = 0; i < 8; ++i) { const int c0 = i * 256 + lane * 4; const float4 pq = *(const float4*)(V + 3 * DM + c0);
        const float4 sc = (isctx || inl) ? *(const float4*)(scv + c0) : *(const float4*)(mg + DM + c0), sh = (isctx || inl) ? *(const float4*)(shv + c0) : *(const float4*)(mg + c0);
        ushort4 o; o.x = f2bf(v[4 * i] * rs * pq.x * (1.f + sc.x) + sh.x); o.y = f2bf(v[4 * i + 1] * rs * pq.y * (1.f + sc.y) + sh.y);
        o.z = f2bf(v[4 * i + 2] * rs * pq.z * (1.f + sc.z) + sh.z); o.w = f2bf(v[4 * i + 3] * rs * pq.w * (1.f + sc.w) + sh.w); *(ushort4*)(hb + c0) = o; }
    }
    R = Rn;
  }
#undef ROW_SRC
  __syncthreads();
}
DI void phase_prep_rows(const Params& p, const int layer) {
  const int lane = opq_tid() & 63, gw = blockIdx.x * 8 + (opq_tid() >> 6), ngw = gridDim.x * 8;
  const float* ct = (const float*)(p.ws + WS_ROPE); const float* st = ct + 64 * 32;
  const int hd = lane >> 4, li = lane & 15, axis = li >> 3, i4 = 4 * (li & 7), d1 = axis * 64 + i4;
  float qw1[4], qw2[4], kw1[4], kw2[4];
#pragma unroll
  for (int j = 0; j < 4; ++j) { qw1[j] = p.qn_w[layer * HD + d1 + j]; qw2[j] = p.qn_w[layer * HD + d1 + 32 + j]; kw1[j] = p.kn_w[layer * HD + d1 + j]; kw2[j] = p.kn_w[layer * HD + d1 + 32 + j]; }
  for (int R = gw; R < MROWS; R += ngw) {
    const int t = R % TOK; const bool isctx = t < CTX; const int pos = t - CTX;
    bf16_t* Ur = (bf16_t*)(p.ws + WS_U) + (size_t)R * NU + hd * HD + d1;
    const bool act1 = hd < 2;
    uint2 u1[4], u2[4];
    u1[0] = *(const uint2*)(Ur + UC_AQ); u2[0] = *(const uint2*)(Ur + UC_AQ + 32);
    if (act1) { u1[1] = *(const uint2*)(Ur + UC_AK); u2[1] = *(const uint2*)(Ur + UC_AK + 32); } else { u1[1] = make_uint2(0u, 0u); u2[1] = make_uint2(0u, 0u); }
    u1[2] = *(const uint2*)(Ur + UC_RQ); u2[2] = *(const uint2*)(Ur + UC_RQ + 32);
    u1[3] = *(const uint2*)(Ur + UC_RK); u2[3] = *(const uint2*)(Ur + UC_RK + 32);
    float cs[4], sn[4];
    if (!isctx) { const int pp = axis == 0 ? (pos >> 6) : (pos & 63); const float4 c4 = *(const float4*)(ct + pp * 32 + i4), s4 = *(const float4*)(st + pp * 32 + i4);
      cs[0] = c4.x; cs[1] = c4.y; cs[2] = c4.z; cs[3] = c4.w; sn[0] = s4.x; sn[1] = s4.y; sn[2] = s4.z; sn[3] = s4.w; }
    else {
#pragma unroll
      for (int j = 0; j < 4; ++j) { cs[j] = 1.f; sn[j] = 0.f; } }
#pragma unroll
    for (int g = 0; g < 4; ++g) {
      float t1[4], t2[4];
      t1[0] = __uint_as_float(u1[g].x << 16); t1[1] = __uint_as_float(u1[g].x & 0xffff0000u); t1[2] = __uint_as_float(u1[g].y << 16); t1[3] = __uint_as_float(u1[g].y & 0xffff0000u);
      t2[0] = __uint_as_float(u2[g].x << 16); t2[1] = __uint_as_float(u2[g].x & 0xffff0000u); t2[2] = __uint_as_float(u2[g].y << 16); t2[3] = __uint_as_float(u2[g].y & 0xffff0000u);
      if (g < 2) { float ss = 0.f;
#pragma unroll
        for (int j = 0; j < 4; ++j) ss += t1[j] * t1[j] + t2[j] * t2[j];
        ss += __shfl_xor(ss, 1); ss += __shfl_xor(ss, 2); ss += __shfl_xor(ss, 4); ss += __shfl_xor(ss, 8);
        const float rs = rsqrtf(ss * (1.f / HD) + EPS);
#pragma unroll
        for (int j = 0; j < 4; ++j) { t1[j] = t1[j] * rs * (g == 0 ? qw1[j] : kw1[j]); t2[j] = t2[j] * rs * (g == 0 ? qw2[j] : kw2[j]); } }
      const float post = g == 3 ? QSCALE : 1.f; float o1[4], o2[4];
#pragma unroll
      for (int j = 0; j < 4; ++j) { o1[j] = (t1[j] * cs[j] - t2[j] * sn[j]) * post; o2[j] = (t2[j] * cs[j] + t1[j] * sn[j]) * post; }
      const int col = g == 0 ? UC_AQ : (g == 1 ? UC_AK : (g == 2 ? UC_RQ : UC_RK));
      if (g != 1 || act1) { *(uint2*)(Ur + col) = make_uint2(scn::cvtpk(o1[0], o1[1]), scn::cvtpk(o1[2], o1[3])); *(uint2*)(Ur + col + 32) = make_uint2(scn::cvtpk(o2[0], o2[1]), scn::cvtpk(o2[2], o2[3])); }
    }
  }
}
DI void signal_done(unsigned* ctr) {
  asm volatile("s_waitcnt vmcnt(0)" ::: "memory"); __syncthreads();
  if (opq_tid() == 0) { __builtin_amdgcn_fence(__ATOMIC_RELEASE, "agent"); __hip_atomic_fetch_add(ctr, 1u, __ATOMIC_RELAXED, __HIP_MEMORY_SCOPE_AGENT); }
}
DI void wait_done(unsigned* ctr, const unsigned want) {
  if (opq_tid() == 0) { unsigned sp = 0; while (__hip_atomic_load(ctr, __ATOMIC_RELAXED, __HIP_MEMORY_SCOPE_AGENT) < want) { __builtin_amdgcn_s_sleep(8); if (++sp > (1u << 22)) break; }
    __builtin_amdgcn_fence(__ATOMIC_ACQUIRE, "agent"); asm volatile("s_waitcnt vmcnt(0)" ::: "memory"); }
  __syncthreads();
}
DI void drain_attention(const Params& p, const int layer, unsigned char* lds, const int max_units) {
  const int nunits = layer == 0 ? 272 : 256;
  unsigned* counter = (unsigned*)(p.ws + WS_CTL) + 16 * layer;
  volatile int* slot = (volatile int*)(lds + LDS_CTL + 64);
  for (int n = 0; n < max_units; ++n) {
    __syncthreads();
    if (opq_tid() == 0) *slot = (int)atomicAdd(counter, 1u);
    __syncthreads();
    const int u = *slot;
    if (u >= nunits) break;
    attn_unit(p, u, (char*)lds);
    if (u >= 256) signal_done((unsigned*)(p.ws + WS_CTL) + 16 * layer + 2);
  }
}
DI void scan_unit(const Params& p, const int layer, const int mix, const int b, const int h, const int blk, unsigned char* lds) {
  if (mix == 0) scn::scan_task<2>(p, layer, b, h, blk, lds); else if (mix == 1) scn::scan_task<0>(p, layer, b, h, blk, lds); else scn::scan_task<1>(p, layer, b, h, blk, lds);
}
template <int layer> DI void phase_mix(const Params& p, unsigned char* lds) {
  constexpr bool need_ctx = layer + 1 < DEPTH;
  unsigned* prepdone = (unsigned*)(p.ws + WS_CTL) + 16 * layer + 1; unsigned* leandone = (unsigned*)(p.ws + WS_CTL) + 16 * layer + 3;
  if (blockIdx.x < 96) { const int bid = blockIdx.x, mix = bid >> 5, b = (bid >> 3) & 3, h = (bid >> 1) & 3, dir = bid & 1;
    if (mix == 0) scn::scan_lean<2>(p, layer, b, h, dir, lds); else if (mix == 1) scn::scan_lean<0>(p, layer, b, h, dir, lds); else scn::scan_lean<1>(p, layer, b, h, dir, lds);
    signal_done(leandone); }
  drain_attention(p, layer, lds, 1 << 30);
  bool leans_in = false;
  volatile int* slot = (volatile int*)(lds + LDS_CTL + 64);
  unsigned* donec = (unsigned*)(p.ws + WS_CTL) + 16 * layer + 2;
  if (need_ctx) { unsigned* counter = (unsigned*)(p.ws + WS_CTL) + 16 * layer + 8;
    for (;;) {
      __syncthreads();
      if (opq_tid() == 0) *slot = (int)atomicAdd(counter, 1u);
      __syncthreads();
      const int u = *slot;
      if (u >= 48) break;
      if (!leans_in) { wait_done(leandone, 96u); leans_in = true; }
      scan_unit(p, layer, u >> 4, (u >> 2) & 3, u & 3, 0, lds);
      signal_done(donec);
    } }
  { unsigned* counter = (unsigned*)(p.ws + WS_CTL) + 16 * layer + 4;
    for (;;) {
      __syncthreads();
      if (opq_tid() == 0) *slot = (int)atomicAdd(counter, 1u);
      __syncthreads();
      const int u = *slot;
      if (u >= 384) break;
      if (!leans_in) { wait_done(leandone, 96u); leans_in = true; }
      const int r = u & 127; scan_unit(p, layer, u >> 7, (r >> 2) & 3, r & 3, 8 - (r >> 4), lds);
    } }
  if (need_ctx) { unsigned* counter = (unsigned*)(p.ws + WS_CTL) + 16 * layer + 6;
    for (;;) {
      __syncthreads();
      if (opq_tid() == 0) *slot = (int)atomicAdd(counter, 1u);
      __syncthreads();
      const int u = *slot;
      if (u >= 32) break;
      wait_done(donec, 48u + 16u);
      const int b = u >> 3, pn = u & 7, pm = 17 * b;
      pg8::Gemm g{(const bf16_t*)(p.ws + WS_HB), (const bf16_t*)(p.ws + WS_WOUT) + (size_t)layer * DM * DM, MROWS, DM, DM}; pg8::OneTile S{pm, pn};
      pg8::EpiBf16 E{(bf16_t*)(p.ws + WS_YC) + ((ptrdiff_t)b * CTX - (ptrdiff_t)pm * 256) * DM, DM, 0};
      pg8::gemm_phase<pg8::EpiBf16, pg8::OneTile, true, true>((PG8_LAS unsigned char*)lds, g, S, E);
    } }
  if (need_ctx) { unsigned* counter = (unsigned*)(p.ws + WS_CTL) + 16 * layer + 10;
    for (;;) {
      __syncthreads();
      if (opq_tid() == 0) *slot = (int)atomicAdd(counter, 1u);
      __syncthreads();
      const int u = *slot;
      if (u >= 264) break;
      phase_convert(p, lds, layer + 1, u, 264);
    } }
}
}

#define GRID_BAR() do { XcdBarrier b_; b_.bar = bar.bar; b_.st = bar.st; asm volatile("" : "+s"(b_.bar)); b_.x = xb_xcc_id(); xcd_barrier(b_); } while (0)
template <int layer> DI void layer_body(const Params& p, unsigned char* lds, const XcdBarrier& bar) {
    { pg8::Gemm g{(const bf16_t*)(p.ws + WS_HB), (const bf16_t*)(p.ws + WS_WIN), MROWS, NU, DM}; pg8::StaticOrder S; S.init(MROWS, NU, (int)gridDim.x, (int)blockIdx.x, 2, (unsigned*)(p.ws + WS_CTL) + 16 * layer + 1);
      pg8::EpiBf16 E{(bf16_t*)(p.ws + WS_U), NU, 1};
      pg8::gemm_phase<pg8::EpiBf16, pg8::StaticOrder, true, true>((PG8_LAS unsigned char*)lds, g, S, E); }
    { unsigned* counter = (unsigned*)(p.ws + WS_CTL) + 16 * layer + 5; volatile int* slot = (volatile int*)(lds + LDS_CTL + 64); bool acq = false;
      for (;;) { __syncthreads(); if (opq_tid() == 0) *slot = (int)atomicAdd(counter, 1u); __syncthreads(); const int u = *slot; if (u >= 48) break;
        if (!acq) { mk::wait_done((unsigned*)(p.ws + WS_CTL) + 16 * layer + 1, 28u); acq = true; }
        if (u < 16) pdn::prep_unit(p, layer, u >> 2, u & 3, 0, lds); else { const int v = (u - 16) >> 1; pdn::prep_unit(p, layer, v >> 2, v & 3, 1 + ((u - 16) & 1), lds); } } }
    GRID_BAR();
    mk::phase_prep_rows(p, layer);
    { unsigned* counter = (unsigned*)(p.ws + WS_CTL) + 16 * layer + 12; volatile int* slot = (volatile int*)(lds + LDS_CTL + 64);
    for (;;) { __syncthreads(); if (opq_tid() == 0) *slot = (int)atomicAdd(counter, 1u); __syncthreads(); const int u = *slot; if (u >= 768) break;
      if (u < 256) pdn::prep_unit(p, layer, u >> 6, 4 + (u & 63), 0, lds); else { const int v = (u - 256) >> 1; pdn::prep_unit(p, layer, v >> 6, 4 + (v & 63), 1 + ((u - 256) & 1), lds); }
      } }
    GRID_BAR();
    mk::phase_mix<layer>(p, lds);
    GRID_BAR();
    { pg8::Gemm g{(const bf16_t*)(p.ws + WS_HB), (const bf16_t*)(p.ws + WS_WOUT) + (size_t)layer * DM * DM, MROWS, DM, DM}; pg8::StaticOrder S;
      S.init(NB * SEQ, DM, (int)gridDim.x, (int)blockIdx.x, 1);
      pg8::EpiBf16 E{(bf16_t*)(p.ws + WS_U), DM, 0};
      pg8::gemm_phase<pg8::EpiBf16, pg8::StaticOrder, true, true>((PG8_LAS unsigned char*)lds, g, S, E); }
    GRID_BAR();
    mk::phase_rows(p, layer, layer + 1 < DEPTH ? layer + 1 : -1, lds);
    if (layer + 1 < DEPTH) GRID_BAR();
}

constexpr int MEGA_LDS = LDS_CTL + 256;
__global__ __launch_bounds__(512) void mega_fwd(Params p) {
  extern __shared__ __attribute__((aligned(16))) unsigned char lds_dyn[];
  cg::grid_group grid = cg::this_grid();
  unsigned char* lds = lds_dyn;
  if (blockIdx.x == 0) { for (int i = opq_tid(); i < 64; i += 512) ((unsigned*)(p.ws + WS_CTL))[i] = 0u; for (int i = opq_tid(); i < XCD_BAR_WORDS; i += 512) ((unsigned*)(p.ws + WS_CTL) + 1024)[i] = 0u; }
  if (opq_tid() < 2) ((LAS unsigned*)(lds + LDS_CTL + 128))[opq_tid()] = 0u;
  __syncthreads();
  grid.sync();
  XcdBarrier bar = xcd_barrier_post((unsigned*)(p.ws + WS_CTL) + 1024, (volatile LAS unsigned*)(lds + LDS_CTL + 128));
  mk::phase_mod(p, lds);
  mk::phase_convert(p, lds, 0);
  mk::phase_rope(p);
  GRID_BAR();
  mk::phase_rows(p, -1, 0, lds);
  GRID_BAR();
  layer_body<0>(p, lds, bar);
  layer_body<1>(p, lds, bar);
}

extern "C" void kernel_launch(void* const* d_in, const int* in_sizes, int n_in, void* d_out, int out_size, void* d_ws, size_t ws_size, hipStream_t stream) {
  if (n_in != 19 || ws_size < WS_END) { fprintf(stderr, "kernel_launch: bad args n_in %d ws %zu need %zu\n", n_in, ws_size, (size_t)WS_END); return; }
  static int grid_blocks = 0;
  if (!grid_blocks) {
    int dev = 0, cus = 0, per_cu = 0;
    hipGetDevice(&dev); hipDeviceGetAttribute(&cus, hipDeviceAttributeMultiprocessorCount, dev);
    if (hipFuncSetAttribute((const void*)mega_fwd, hipFuncAttributeMaxDynamicSharedMemorySize, MEGA_LDS) != hipSuccess) fprintf(stderr, "hipFuncSetAttribute failed\n");
    hipOccupancyMaxActiveBlocksPerMultiprocessor(&per_cu, (const void*)mega_fwd, 512, MEGA_LDS);
    if (per_cu < 1) { fprintf(stderr, "occupancy query returned %d\n", per_cu); per_cu = 1; }
    grid_blocks = cus * 1;
    if (grid_blocks < 48) fprintf(stderr, "grid too small\n");
  }
  Params p{};
  const float** pp = (const float**)&p;
  for (int i = 0; i < 19; ++i) pp[i] = (const float*)d_in[i];
  p.out = (float*)d_out; p.ws = (unsigned char*)d_ws;
  void* args[] = {&p};
  hipError_t e = hipLaunchCooperativeKernel((const void*)mega_fwd, dim3(grid_blocks), dim3(512), args, MEGA_LDS, stream);
  if (e != hipSuccess) fprintf(stderr, "cooperative launch failed: %s (grid %d)\n", hipGetErrorString(e), grid_blocks);
}
```

```cpp
#include <hip/hip_runtime.h>
#include <cstdio>
#include <cstdint>
#include <hip/hip_cooperative_groups.h>
namespace cg = cooperative_groups;

typedef unsigned short bf16_t;
#define DI __device__ __forceinline__

constexpr int DM = 2048, NB = 4, SEQ = 4096, CTX = 256, TOK = SEQ + CTX, MROWS = NB * TOK;
constexpr int NIN = 8224, NU = 8448, HD = 128, NH = 4, GW = 512, DEPTH = 2;
constexpr float EPS = 1e-6f;
constexpr float QSCALE = 0.08838834764831845f;
constexpr int UC_MQ = 0, UC_MK = 512, UC_MV = 1024, UC_MO = 1536, UC_MZ = 2048, UC_RQ = 2560, UC_RK = 3072, UC_RV = 3584, UC_RZ = 4096,
              UC_AQ = 4608, UC_AK = 5120, UC_AV = 5376, UC_AZ = 5632, UC_DQ = 6144, UC_DZ = 7680, UC_MI = 8192, UC_MF = 8200, UC_DA = 8208, UC_DB = 8216;
constexpr int MG_M = 0, MG_R = 512, MG_A = 1024, MG_D = 1536;

constexpr size_t MiB = 1u << 20;
constexpr size_t WS_CTL = 0;
constexpr size_t WS_MOD = 64 * 1024;
constexpr size_t WS_ROPE = 512 * 1024;
constexpr size_t WS_WIN = 1 * MiB;
constexpr size_t WS_WOUT = WS_WIN + (size_t)1 * NU * DM * 2;
constexpr size_t WS_HB = WS_WOUT + (size_t)2 * DM * DM * 2;
constexpr size_t WS_XC = WS_HB + (size_t)MROWS * DM * 2;
constexpr size_t WS_DQ = WS_XC + (size_t)NB * CTX * DM * 4;
constexpr size_t WS_TB = WS_DQ + (size_t)MROWS * 1536 * 2;
constexpr size_t WS_U = WS_TB + (size_t)NB * NH * 2 * (TOK / 64) * 4096 * 2;
constexpr size_t WS_GP = WS_U + (size_t)MROWS * NU * 2;
constexpr size_t WS_CK = WS_GP + (size_t)MROWS * 56 * 4;
constexpr size_t WS_CKN = WS_CK + (size_t)96 * 8 * 16384 * 2;
constexpr size_t WS_YC = WS_CKN + (size_t)96 * 8 * 132 * 4;
constexpr size_t WS_END = WS_YC + (size_t)NB * CTX * DM * 2;
constexpr int GPW = 56;

struct Params {
  const float *x, *c, *ctx, *c_ctx, *ada_w, *ada_b, *pre_w, *post_w, *w_in, *w_out, *m_ib, *m_fb, *r_lg, *qn_w, *kn_w, *conv_w, *a_log, *dt_bias, *hn_w;
  float* out; unsigned char* ws;
};

DI int opq_tid() { int t = (int)threadIdx.x; asm volatile("" : "+v"(t)); return t; }
DI float bf2f(bf16_t v) { return __uint_as_float(((unsigned)v) << 16); }
DI bf16_t f2bf(float f) { unsigned u = __float_as_uint(f); return (bf16_t)((u + 0x7fffu + ((u >> 16) & 1u)) >> 16); }
DI float wave_sum(float v) {
#pragma unroll
  for (int o = 1; o < 64; o <<= 1) v += __shfl_xor(v, o);
  return v;
}
DI float siluf(float x) { return x * __builtin_amdgcn_rcpf(1.f + __expf(-x)); }
DI float sigmoidf(float x) { return __builtin_amdgcn_rcpf(1.f + __expf(-x)); }
DI float softplusf(float x) { return x > 20.f ? x : log1pf(__expf(x)); }
DI float logsigmoidf(float x) { return x < -20.f ? x : -log1pf(__expf(-x)); }
DI int ucol_src(int n) { return n < 2560 ? n : (n < 8192 ? n + 16 : (n < 8208 ? 2560 + (n - 8192) : (n < 8224 ? n : -1))); }


namespace pg8 {
#define PG8_LAS __attribute__((address_space(3)))
typedef unsigned short bf16_t;
typedef short bf16x8 __attribute__((ext_vector_type(8)));
typedef float f32x4 __attribute__((ext_vector_type(4)));
typedef unsigned u32x4 __attribute__((ext_vector_type(4)));
constexpr int BM = 256, BK = 64, HALF = 128, HTB = HALF * BK * 2  , STAGE_BYTES = 8 * HTB, NXCD = 8, WGM = 8;

__host__ __device__ __forceinline__ int lds_byte(int r, int c) { const int st = (r >> 4) * 2 + (c >> 5), rr = r & 15, cc = c & 31, ob = rr * 64 + cc * 2; return st * 1024 + (ob ^ (((ob >> 9) & 1) << 5)); }
__host__ __device__ __forceinline__ void stage_rc(int b, int& R, int& C) { const int st = b / 1024, sb = b % 1024, swz = sb ^ (((sb >> 9) & 1) << 5); R = (st >> 1) * 16 + swz / 64; C = (st & 1) * 32 + (swz % 64) / 2; }
__host__ __device__ __forceinline__ int perm32(int rho) { const int n = rho >> 4, i = rho & 15; return 8 * (i >> 2) + 4 * n + (i & 3); }

struct Unit { int pm, pn; };
struct Gemm { const bf16_t* A; const bf16_t* Bt; int M, N, K; };

struct StaticOrder {
    int nM, nN, nwg, G, c, skip;
    unsigned* sig;
    __host__ __device__ void init(int M, int N, int G_, int c_, int skip_ = 0, unsigned* sig_ = nullptr) { nM = M / BM; nN = N / BM; nwg = nM * nN; G = G_; c = c_; skip = skip_; sig = sig_; }
    __host__ __device__ bool next(int i, Unit& u) const {
        const long L = (long)i * G + c; if (L >= nwg) return false;
        int wgid = (int)L; { const int q = nwg / NXCD, r = nwg % NXCD, xcd = wgid % NXCD, off = wgid / NXCD; wgid = (xcd < r ? xcd * (q + 1) : r * (q + 1) + (xcd - r) * q) + off; }
        const int nig = WGM * nN, gid = wgid / nig, fm = gid * WGM, gsz = (nM - fm) < WGM ? (nM - fm) : WGM;
        u.pm = fm + ((wgid % nig) % gsz); u.pn = (wgid % nig) / gsz; if (skip == 1) u.pm += u.pm / 16 + 1;
        if (skip == 2) { u.pm = u.pm < 4 ? 17 * u.pm : (u.pm - 4) + (u.pm - 4) / 16 + 1; u.pn = u.pn < 6 ? 24 + u.pn : (u.pn == 6 ? 32 : (u.pn < 31 ? u.pn - 7 : u.pn - 1)); }
        return true;
    }
    __device__ __forceinline__ void a_ready(const Unit&) const {}
    __device__ __forceinline__ void done(const Unit& u) const {
        if (skip == 2 && (u.pm % 17) == 0 && ((u.pn >= 24 && u.pn < 30) || u.pn == 32)) {
            asm volatile("s_waitcnt vmcnt(0)" ::: "memory"); __syncthreads();
            if (threadIdx.x == 0) { __builtin_amdgcn_fence(__ATOMIC_RELEASE, "agent"); __hip_atomic_fetch_add(sig, 1u, __ATOMIC_RELAXED, __HIP_MEMORY_SCOPE_AGENT); } }
    }
};


struct OneTile { int pm, pn;
    __device__ __forceinline__ bool next(int i, Unit& u) const { if (i) return false; u.pm = pm; u.pn = pn; return true; }
    __device__ __forceinline__ void a_ready(const Unit&) const {}
    __device__ __forceinline__ void done(const Unit&) const {}
};

__device__ __forceinline__ unsigned cvt_pk_bf16(float lo, float hi) { unsigned r; asm volatile("v_cvt_pk_bf16_f32 %0, %1, %2" : "=v"(r) : "v"(lo), "v"(hi)); return r; }
struct EpiBf16 {
    static constexpr bool PERM = true, AFTER_DRAIN = false;
    bf16_t* O; int ldc; int actmode;
    __device__ __forceinline__ void operator()(const f32x4 (&acc)[2][2][4][2], const Unit& u, int wr, int wc, int fr, int fq) const {
        const int row0 = u.pm * BM + wr * 64 + fr; const int col0 = u.pn * BM + wc * 32 + 8 * fq;
        int act = 0; const bool padt = actmode && u.pn == 32;
        if (actmode) { const int pn = u.pn; if (pn == 6 || pn == 7) act = 2; else if (pn == 8 || pn == 9 || pn == 16 || pn == 17 || pn == 22 || pn == 23 || pn == 30 || pn == 31) act = 1; }
#pragma unroll
        for (int ai = 0; ai < 2; ++ai)
#pragma unroll
            for (int m = 0; m < 4; ++m) { bf16_t* rowp = O + (size_t)(row0 + ai * HALF + m * 16) * ldc + col0;
#pragma unroll
                for (int bj = 0; bj < 2; ++bj) { f32x4 v0 = acc[ai][bj][m][0], v1 = acc[ai][bj][m][1];
                    if (padt && (wc != 0 || bj != 0)) continue;
                    if (act) {
#pragma unroll
                        for (int e = 0; e < 4; ++e) { const float s0 = __builtin_amdgcn_rcpf(1.f + __expf(-v0[e])), s1 = __builtin_amdgcn_rcpf(1.f + __expf(-v1[e])); v0[e] = act == 1 ? v0[e] * s0 : s0; v1[e] = act == 1 ? v1[e] * s1 : s1; } }
                    u32x4 w; w.x = cvt_pk_bf16(v0[0], v0[1]); w.y = cvt_pk_bf16(v0[2], v0[3]); w.z = cvt_pk_bf16(v1[0], v1[1]); w.w = cvt_pk_bf16(v1[2], v1[3]);
                    *(u32x4*)(rowp + bj * HALF) = w; } }
    }
};

template <class Epi, class Sched, bool ALIGN_EPI = false, bool SP2 = false>
__device__ __forceinline__ void gemm_phase(PG8_LAS unsigned char* lds, const Gemm g, const Sched& S, const Epi& E) {
    const int tid = opq_tid(), wid = __builtin_amdgcn_readfirstlane(tid >> 6), lane = tid & 63, wr = wid >> 2, wc = wid & 3, fr = lane & 15, fq = lane >> 4;
    const int K = g.K, nt = K / BK;
    unsigned voffA[2], voffB[2];
#pragma unroll
    for (int i = 0; i < 2; ++i) { int R, C; stage_rc(tid * 16 + i * 8192, R, C); const int Rb = Epi::PERM ? ((R & ~31) + perm32(R & 31)) : R;
        voffA[i] = (unsigned)(R * K + C) * 2u; voffB[i] = (unsigned)(Rb * K + C) * 2u; }
    const size_t kstep = (size_t)(BK * 2);
    const size_t hstep = (size_t)HALF * K * 2;
    const size_t tstep = 2 * hstep;
    const unsigned ldsw = (unsigned)wid * 1024u;
    const int aoff = lds_byte(wr * 64 + fr, fq * 8), boff = lds_byte(wc * 32 + fr, fq * 8);
#define PG8_SA(b, h) (((b) * 2 + (h)) * HTB)
#define PG8_SB(b, h) ((4 + (b) * 2 + (h)) * HTB)
#define PG8_STAGE(bufoff, gbase, voff) do { _Pragma("unroll") for (int _i = 0; _i < 2; ++_i) \
        __builtin_amdgcn_global_load_lds((const unsigned*)((const char*)(gbase) + (voff)[_i]), (PG8_LAS unsigned*)(lds + (bufoff) + ldsw + _i * 8192), 16, 0, 0); } while (0)
#define PG8_LDA(dst, b, h) do { _Pragma("unroll") for (int m = 0; m < 4; ++m) _Pragma("unroll") for (int k = 0; k < 2; ++k) dst[m][k] = *(const PG8_LAS bf16x8*)(lds + PG8_SA(b, h) + aoff + m * 2048 + k * 1024); } while (0)
#define PG8_LDB(dst, b, h) do { _Pragma("unroll") for (int n = 0; n < 2; ++n) _Pragma("unroll") for (int k = 0; k < 2; ++k) dst[n][k] = *(const PG8_LAS bf16x8*)(lds + PG8_SB(b, h) + boff + n * 2048 + k * 1024); } while (0)
#define PG8_MMA(ai, bj, At, Bt) do { __builtin_amdgcn_s_setprio(1); _Pragma("unroll") for (int m = 0; m < 4; ++m) _Pragma("unroll") for (int n = 0; n < 2; ++n) _Pragma("unroll") for (int k = 0; k < 2; ++k) \
        acc[ai][bj][m][n] = __builtin_amdgcn_mfma_f32_16x16x32_bf16(Bt[n][k], At[m][k], acc[ai][bj][m][n], 0, 0, 0); __builtin_amdgcn_s_setprio(0); } while (0)
#define PG8_WAIT_V(n) asm volatile("s_waitcnt vmcnt(" #n ")" ::: "memory")
#define PG8_WAIT_L(n) asm volatile("s_waitcnt lgkmcnt(" #n ")" ::: "memory")
#define PG8_BAR __builtin_amdgcn_s_barrier()
#define PG8_SCHED __builtin_amdgcn_sched_barrier(0)
    Unit cur, nxt; int ui = 0;
    if (!S.next(0, cur)) return;
    f32x4 acc[2][2][4][2];
#pragma unroll
    for (int a = 0; a < 2; ++a)
#pragma unroll
        for (int b = 0; b < 2; ++b)
#pragma unroll
            for (int m = 0; m < 4; ++m)
#pragma unroll
                for (int n = 0; n < 2; ++n) acc[a][b][m][n] = (f32x4){0.f, 0.f, 0.f, 0.f};
    bf16x8 At[4][2], B0[2][2], B1[2][2];
    const char* cA = (const char*)g.A + (size_t)cur.pm * tstep; const char* cB = (const char*)g.Bt + (size_t)cur.pn * tstep;
    S.a_ready(cur);
    if constexpr (SP2) {
        PG8_STAGE(PG8_SB(0, 0), cB, voffB); PG8_STAGE(PG8_SB(0, 1), cB + hstep, voffB); PG8_STAGE(PG8_SA(0, 0), cA, voffA); PG8_STAGE(PG8_SA(0, 1), cA + hstep, voffA);
        if (wr == 1) PG8_BAR;
        PG8_WAIT_V(2); PG8_BAR;
        PG8_STAGE(PG8_SB(1, 0), cB + kstep, voffB); PG8_STAGE(PG8_SA(1, 0), cA + kstep, voffA); PG8_STAGE(PG8_SB(1, 1), cB + hstep + kstep, voffB);
        PG8_WAIT_V(6); PG8_BAR;
    } else {
        PG8_STAGE(PG8_SB(0, 0), cB, voffB); PG8_STAGE(PG8_SA(0, 0), cA, voffA); PG8_STAGE(PG8_SB(0, 1), cB + hstep, voffB); PG8_STAGE(PG8_SA(0, 1), cA + hstep, voffA);
        if (wr == 1) PG8_BAR;
        PG8_WAIT_V(4); PG8_BAR;
        PG8_STAGE(PG8_SB(1, 0), cB + kstep, voffB); PG8_STAGE(PG8_SA(1, 0), cA + kstep, voffA); PG8_STAGE(PG8_SB(1, 1), cB + hstep + kstep, voffB);
        PG8_WAIT_V(6); PG8_BAR;
    }
    for (;;) {
        const bool has_next = S.next(ui + 1, nxt);
        const char* nA = has_next ? (const char*)g.A + (size_t)nxt.pm * tstep : cA; const char* nB = has_next ? (const char*)g.Bt + (size_t)nxt.pn * tstep : cB;
        for (int t = 0; t < nt; t += 2) {
            const bool last = (t == nt - 2);
            const char* a1 = cA + (size_t)(t + 1) * kstep;
            const char* a2 = last ? nA : cA + (size_t)(t + 2) * kstep; const char* b2 = last ? nB : cB + (size_t)(t + 2) * kstep;
            const char* a3 = a2 + kstep; const char* b3 = b2 + kstep;
            if (last && has_next) S.a_ready(nxt);
            if constexpr (SP2) {
            PG8_LDB(B0, 0, 0); PG8_LDB(B1, 0, 1); PG8_SCHED; PG8_LDA(At, 0, 0); PG8_STAGE(PG8_SA(1, 1), a1 + hstep, voffA);
            PG8_WAIT_V(8); PG8_WAIT_L(0); PG8_BAR; PG8_MMA(0, 0, At, B0); PG8_MMA(0, 1, At, B1); PG8_BAR; PG8_SCHED;
            PG8_LDA(At, 0, 1); PG8_STAGE(PG8_SB(0, 0), b2, voffB); PG8_STAGE(PG8_SB(0, 1), b2 + hstep, voffB); PG8_STAGE(PG8_SA(0, 0), a2, voffA);
            PG8_WAIT_V(8); PG8_WAIT_L(0); PG8_BAR; PG8_MMA(1, 0, At, B0); PG8_MMA(1, 1, At, B1); PG8_BAR; PG8_SCHED;
            PG8_LDB(B0, 1, 0); PG8_LDB(B1, 1, 1); PG8_SCHED; PG8_LDA(At, 1, 0); PG8_STAGE(PG8_SA(0, 1), a2 + hstep, voffA);
            PG8_WAIT_V(8); PG8_WAIT_L(0); PG8_BAR; PG8_MMA(0, 0, At, B0); PG8_MMA(0, 1, At, B1); PG8_BAR; PG8_SCHED;
            PG8_LDA(At, 1, 1); PG8_STAGE(PG8_SB(1, 0), b3, voffB); PG8_STAGE(PG8_SB(1, 1), b3 + hstep, voffB); PG8_STAGE(PG8_SA(1, 0), a3, voffA);
            PG8_WAIT_V(8); PG8_WAIT_L(0); PG8_BAR; PG8_MMA(1, 0, At, B0); PG8_MMA(1, 1, At, B1); PG8_BAR; PG8_SCHED;
            } else {
            PG8_LDB(B0, 0, 0); PG8_SCHED; PG8_LDA(At, 0, 0); PG8_STAGE(PG8_SA(1, 1), a1 + hstep, voffA);
            PG8_WAIT_L(8); PG8_BAR; PG8_WAIT_L(0); PG8_MMA(0, 0, At, B0); PG8_BAR; PG8_SCHED;
            PG8_LDB(B1, 0, 1); PG8_STAGE(PG8_SB(0, 0), b2, voffB);
            PG8_BAR; PG8_WAIT_L(0); PG8_MMA(0, 1, At, B1); PG8_BAR;
            PG8_LDA(At, 0, 1); PG8_STAGE(PG8_SA(0, 0), a2, voffA);
            PG8_BAR; PG8_WAIT_L(0); PG8_MMA(1, 0, At, B0); PG8_BAR; PG8_SCHED;
            PG8_STAGE(PG8_SB(0, 1), b2 + hstep, voffB);
            PG8_WAIT_V(6); PG8_BAR; PG8_MMA(1, 1, At, B1); PG8_BAR;
            PG8_LDB(B0, 1, 0); PG8_SCHED; PG8_LDA(At, 1, 0); PG8_STAGE(PG8_SA(0, 1), a2 + hstep, voffA);
            PG8_WAIT_L(8); PG8_BAR; PG8_WAIT_L(0); PG8_MMA(0, 0, At, B0); PG8_BAR; PG8_SCHED;
            PG8_LDB(B1, 1, 1); PG8_STAGE(PG8_SB(1, 0), b3, voffB);
            PG8_BAR; PG8_WAIT_L(0); PG8_MMA(0, 1, At, B1); PG8_BAR;
            PG8_LDA(At, 1, 1); PG8_STAGE(PG8_SA(1, 0), a3, voffA);
            PG8_BAR; PG8_WAIT_L(0); PG8_MMA(1, 0, At, B0); PG8_BAR; PG8_SCHED;
            PG8_STAGE(PG8_SB(1, 1), b3 + hstep, voffB);
            PG8_WAIT_V(6); PG8_BAR; PG8_MMA(1, 1, At, B1); PG8_BAR;
            }
        }
        if constexpr (ALIGN_EPI) { if (wr == 0) PG8_BAR; }
        if constexpr (!Epi::AFTER_DRAIN) { E(acc, cur, wr, wc, fr, fq); S.done(cur); }
        if (!has_next) break;
#pragma unroll
        for (int a = 0; a < 2; ++a)
#pragma unroll
            for (int b = 0; b < 2; ++b)
#pragma unroll
                for (int m = 0; m < 4; ++m)
#pragma unroll
                    for (int n = 0; n < 2; ++n) acc[a][b][m][n] = (f32x4){0.f, 0.f, 0.f, 0.f};
        cur = nxt; cA = nA; cB = nB; ++ui;
        if constexpr (ALIGN_EPI) { if (wr == 1) PG8_BAR; }
    }
    PG8_WAIT_V(0);
    if constexpr (!ALIGN_EPI) { if (wr == 0) PG8_BAR; }
    PG8_BAR;
    if constexpr (Epi::AFTER_DRAIN) { E.fused(acc, cur, wr, wc, fr, fq, lds, wid, lane); S.done(cur); }
#undef PG8_SA
#undef PG8_SB
#undef PG8_STAGE
#undef PG8_LDA
#undef PG8_LDB
#undef PG8_MMA
#undef PG8_WAIT_V
#undef PG8_WAIT_L
#undef PG8_BAR
#undef PG8_SCHED
}
}

namespace scn {
typedef short bf16x8 __attribute__((ext_vector_type(8)));
typedef short bf16x4 __attribute__((ext_vector_type(4)));
typedef float f32x4 __attribute__((ext_vector_type(4)));
typedef unsigned u32x4 __attribute__((ext_vector_type(4)));
typedef float f32x2_t __attribute__((ext_vector_type(2))); typedef __bf16 bf16x2_t __attribute__((ext_vector_type(2)));
constexpr int QS = 136, KS_ = 144, TS = 72, OSS = 132;
constexpr int QSB = QS * 2, KSB = KS_ * 2, TSB = TS * 2;
constexpr int L_Q = 0, L_K = L_Q + 64 * QSB, L_V = L_K + 64 * KSB, L_T = L_V + 64 * KSB, L_AS = L_T + 64 * TSB, L_OS = L_AS + 64 * TSB, L_G = L_OS + 64 * OSS * 4,
              L_N = L_G + 2 * 448 * 4, L_NP = L_N + 2 * 128 * 4, L_DEN = L_NP + 4 * 128 * 4, L_HN = L_DEN + 64 * 4, L_END = L_HN + 128 * 4;
constexpr int NCH = TOK / 64;
DI unsigned cvtpk(float lo, float hi) { f32x2_t v = {lo, hi}; bf16x2_t b = __builtin_convertvector(v, bf16x2_t); return __builtin_bit_cast(unsigned, b); }
DI bf16x8 pack2(f32x4 a, f32x4 b) { u32x4 w = {cvtpk(a[0], a[1]), cvtpk(a[2], a[3]), cvtpk(b[0], b[1]), cvtpk(b[2], b[3])}; return __builtin_bit_cast(bf16x8, w); }
DI int pcol(int c) { const int o = c & 31; return (c & ~31) + (o < 16 ? 8 * (o >> 2) + (o & 3) : 8 * ((o - 16) >> 2) + 4 + (o & 3)); }
DI int unpcol(int pos) { const int q = pos & 31, gg = q >> 3, j = q & 7; return (pos & ~31) + (j < 4 ? 4 * gg + j : 16 + 4 * gg + (j - 4)); }
DI bf16x8 ld_perm(const unsigned char* rowp, int kb, int g) { return *(const bf16x8*)(rowp + (kb * 32 + 8 * g) * 2); }
typedef short v4i16_t __attribute__((ext_vector_type(4)));
DI bf16x4 tr_read(const unsigned char* p) { return __builtin_bit_cast(bf16x4, __builtin_amdgcn_ds_read_tr16_b64_v4i16((__attribute__((address_space(3))) v4i16_t*)p)); }
DI bf16x8 tr_pair(const unsigned char* p, int rowstep16_bytes) { const bf16x4 lo = tr_read(p), hi = tr_read(p + rowstep16_bytes); return __builtin_shufflevector(lo, hi, 0, 1, 2, 3, 4, 5, 6, 7); }
DI float wave_psum(float v, int lane) {
#pragma unroll
  for (int o = 1; o < 64; o <<= 1) { const float u = __shfl_up(v, o); if (lane >= o) v += u; }
  return v;
}
DI float wave_pmax(float v, int lane) {
#pragma unroll
  for (int o = 1; o < 64; o <<= 1) { const float u = __shfl_up(v, o); if (lane >= o) v = fmaxf(v, u); }
  return v;
}
DI int row_of(int dir, int pos) { return dir == 0 ? pos : (pos < CTX ? CTX - 1 - pos : TOK + CTX - 1 - pos); }
#define MFMA16(a, b, c) __builtin_amdgcn_mfma_f32_16x16x32_bf16((a), (b), (c), 0, 0, 0)

template <int MIX>
DI void scan_task(const Params& p, const int layer, const int b, const int h, const int blk, unsigned char* lds) {
  const int tid = opq_tid(), lane = tid & 63, w = __builtin_amdgcn_readfirstlane(tid >> 6), c16 = lane & 15, g = lane >> 4;
  const bf16_t* U = (const bf16_t*)(p.ws + WS_U); bf16_t* MG = (bf16_t*)(p.ws + WS_HB);
  const bf16_t* src = MIX == 2 ? (const bf16_t*)(p.ws + WS_DQ) : U;
  constexpr int rstride = MIX == 2 ? 1536 : NU;
  const int qoff = (MIX == 0 ? UC_MQ : (MIX == 1 ? UC_RQ : 0)) + h * HD, koff = (MIX == 0 ? UC_MK : (MIX == 1 ? UC_RK : 512)) + h * HD, voff = (MIX == 0 ? UC_MV : (MIX == 1 ? UC_RV : 1024)) + h * HD;
  const int zc = (MIX == 0 ? UC_MZ : (MIX == 1 ? UC_RZ : UC_DZ)) + h * HD, mgc = (MIX == 0 ? MG_M : (MIX == 1 ? MG_R : MG_D)) + h * HD;
  const bf16_t* TB = (const bf16_t*)(p.ws + WS_TB) + (size_t)((b * NH + h) * 2) * NCH * 4096;
  float* nbuf = (float*)(lds + L_N); float* NP = (float*)(lds + L_NP); float* DEN = (float*)(lds + L_DEN); float* HN = (float*)(lds + L_HN);
  bf16_t* ASl = (bf16_t*)(lds + L_AS); float* OSl = (float*)(lds + L_OS);
  const int trb = (4 * g + (c16 >> 2)) * KSB + (c16 & 3) * 8;
  const int trk = (4 * g + (c16 >> 2)) * KSB + (c16 & 3) * 16;
  const int nst = blk == 0 ? 4 : 8, blk1 = blk == 0 ? 0 : 9 - blk, c0 = blk == 0 ? 0 : 8 * blk - 4, c1 = blk1 == 0 ? 0 : 8 * blk1 - 4;
  const int seq0 = ((MIX * NB + b) * NH + h) * 2;
#define SCN_DIR(s_) ((s_) >= nst ? 1 : 0)
#define SCN_CC(s_) ((s_) >= nst ? c1 + (s_) - nst : c0 + (s_))
  f32x4 S[8];
#pragma unroll
  for (int i = 0; i < 8; ++i) S[i] = (f32x4){0.f, 0.f, 0.f, 0.f};
  u32x4 rq[2], rk[2], rv[2], rt; float ga = 0.f, gb = 0.f, gc = 0.f, gd = 0.f; float m_state = 0.f;
  rt = (u32x4){0u, 0u, 0u, 0u};

#define SCN_ISSUE(st_) do { const int dir_ = SCN_DIR(st_), cc_ = SCN_CC(st_);                                                             \
    _Pragma("unroll") for (int i_ = 0; i_ < 2; ++i_) { const int idx_ = tid + 512 * i_, t_ = idx_ >> 4, pc_ = idx_ & 15;                 \
      const size_t R_ = (size_t)b * TOK + row_of(dir_, 64 * cc_ + t_); const bf16_t* rp_ = src + R_ * rstride + pc_ * 8;                    \
      rq[i_] = *(const u32x4*)(rp_ + qoff); rk[i_] = *(const u32x4*)(rp_ + koff); rv[i_] = *(const u32x4*)(rp_ + voff); }                   \
    if (MIX == 2) rt = *(const u32x4*)(TB + (size_t)(dir_ * NCH + cc_) * 4096 + (tid >> 3) * 64 + (tid & 7) * 8);                            \
    if (w == 0 && MIX != 1) { const size_t R_ = (size_t)b * TOK + row_of(dir_, 64 * cc_ + lane); const float* gp_ = (const float*)(p.ws + WS_GP) + R_ * GPW;   \
      if (MIX == 0) { gp_ += (dir_ * 4 + h) * 3; ga = gp_[0]; gb = gp_[1]; gc = gp_[2]; }                                                  \
      else { const f32x4 q_ = *(const f32x4*)(gp_ + 24 + (dir_ * 4 + h) * 4); ga = q_[0]; gb = q_[1]; gc = q_[2]; gd = q_[3]; } } } while (0)

#define SCN_COMMIT(st_) do { const int dir_ = SCN_DIR(st_); float* gt_ = (float*)(lds + L_G) + ((st_) & 1) * 448;                          \
    _Pragma("unroll") for (int i_ = 0; i_ < 2; ++i_) { const int idx_ = tid + 512 * i_, t_ = idx_ >> 4, pc_ = idx_ & 15;                 \
      const int po_ = ((pc_ >> 2) * 32 + (pc_ & 1) * 16 + ((pc_ >> 1) & 1) * 4) * 2;                                                          \
      *(unsigned long long*)(lds + L_Q + t_ * QSB + po_) = (unsigned long long)rq[i_][0] | ((unsigned long long)rq[i_][1] << 32); *(unsigned long long*)(lds + L_Q + t_ * QSB + po_ + 16) = (unsigned long long)rq[i_][2] | ((unsigned long long)rq[i_][3] << 32); \
      *(unsigned long long*)(lds + L_K + t_ * KSB + po_) = (unsigned long long)rk[i_][0] | ((unsigned long long)rk[i_][1] << 32); *(unsigned long long*)(lds + L_K + t_ * KSB + po_ + 16) = (unsigned long long)rk[i_][2] | ((unsigned long long)rk[i_][3] << 32); \
      *(u32x4*)(lds + L_V + t_ * KSB + pc_ * 16) = rv[i_]; } \
    if (MIX == 2) *(u32x4*)(lds + L_T + (tid >> 3) * TSB + (tid & 7) * 16) = rt;                                                           \
    if (w == 0) { const int gi_ = layer * 8 + dir_ * 4 + h; float rowf_, colf_, alpha_, wv_, beta_ = 0.f, ninv_ = 0.f, cd_;                  \
      if (MIX == 0 && ((st_) == 0 || (st_) == nst)) { const int ck_ = ((st_) == 0 ? blk : blk1) - 1; m_state = ck_ >= 0 ? ((const float*)(p.ws + WS_CKN))[((size_t)(seq0 + dir_) * 8 + ck_) * 132 + 128] : 0.f; } \
      if (MIX == 0) { const float a_ = ga, run_ = fmaxf(m_state, gb); const float run63_ = __shfl(run_, 63), bend_ = __shfl(gc, 63);                 \
        rowf_ = -run_; colf_ = a_; alpha_ = __expf(m_state - run_); wv_ = __expf(a_ - run63_); ninv_ = __expf(-(gc + run_)); cd_ = __expf(m_state - run63_); m_state = bend_ + run63_; } \
      else if (MIX == 1) { const float lg_ = p.r_lg[gi_]; rowf_ = lg_ * (float)lane; colf_ = -rowf_; alpha_ = __expf(lg_ * (float)(lane + 1)); wv_ = __expf(lg_ * (float)(63 - lane)); cd_ = __expf(lg_ * 64.f); } \
      else { rowf_ = ga; colf_ = -ga; alpha_ = gb; wv_ = gc; beta_ = gd; cd_ = __shfl(gb, 63); }                                              \
      gt_[lane] = rowf_; gt_[64 + lane] = colf_; gt_[128 + lane] = alpha_; gt_[192 + lane] = wv_; gt_[256 + lane] = beta_; gt_[320 + lane] = ninv_; if (lane == 0) gt_[384] = cd_; } } while (0)

  if (tid < 256) nbuf[tid] = 0.f;
  if (tid < 128) HN[tid] = p.hn_w[layer * 1536 + (MIX == 0 ? 0 : (MIX == 1 ? 512 : 1024)) + h * HD + tid];
  SCN_ISSUE(0); SCN_COMMIT(0);
  for (int st = 0; st < 2 * nst; ++st) {
    const int dir = SCN_DIR(st), cc = SCN_CC(st);
    const float* gts = (const float*)(lds + L_G) + (st & 1) * 448;
    if (st == 0 || st == nst) {
      const int ck = (st == 0 ? blk : blk1) - 1;
      if (ck >= 0) { const unsigned long long* cp = (const unsigned long long*)(p.ws + WS_CK) + (((size_t)(seq0 + dir) * 8 + ck) * 8 + w) * 8 * 64 + lane;
#pragma unroll
        for (int i = 0; i < 8; ++i) { const unsigned long long q = cp[i * 64]; const unsigned lo = (unsigned)q, hi = (unsigned)(q >> 32);
          S[i] = (f32x4){__uint_as_float(lo << 16), __uint_as_float(lo & 0xffff0000u), __uint_as_float(hi << 16), __uint_as_float(hi & 0xffff0000u)}; }
      } else {
#pragma unroll
        for (int i = 0; i < 8; ++i) S[i] = (f32x4){0.f, 0.f, 0.f, 0.f}; }
      if (MIX == 0 && tid < 128) nbuf[(st & 1) * 128 + tid] = ck >= 0 ? ((const float*)(p.ws + WS_CKN))[((size_t)(seq0 + dir) * 8 + ck) * 132 + tid] : 0.f;
    }
    __syncthreads();
    if (st + 1 < 2 * nst) SCN_ISSUE(st + 1);
    { const int tb = w >> 1;
#pragma unroll
      for (int q2 = 0; q2 < 2; ++q2) { const int sb = 2 * (w & 1) + q2; f32x4 acc = (f32x4){0.f, 0.f, 0.f, 0.f};
        if (sb <= tb) {
          bf16x8 fa[4], fb[4];
#pragma unroll
          for (int kb = 0; kb < 4; ++kb) { fa[kb] = *(const bf16x8*)(lds + L_Q + (16 * tb + c16) * QSB + kb * 64 + g * 16); fb[kb] = *(const bf16x8*)(lds + L_K + (16 * sb + c16) * KSB + kb * 64 + g * 16); }
          __builtin_amdgcn_sched_barrier(0);
#pragma unroll
          for (int kb = 0; kb < 4; ++kb) acc = MFMA16(fa[kb], fb[kb], acc);
          const float cf = gts[64 + 16 * sb + c16]; const f32x4 rf = *(const f32x4*)(gts + 16 * tb + 4 * g);
#pragma unroll
          for (int r = 0; r < 4; ++r) { const int t = 16 * tb + 4 * g + r, s = 16 * sb + c16; acc[r] = (s <= t) ? acc[r] * __expf(rf[r] + cf) : 0.f; }
        }
#pragma unroll
        for (int r = 0; r < 4; ++r) ASl[(16 * tb + 4 * g + r) * TS + pcol(16 * sb + c16)] = (bf16_t)(cvtpk(acc[r], 0.f) & 0xffffu);
      } }
    __syncthreads();
    const int et = tid >> 3, epart = tid & 7; const size_t eR = (size_t)b * TOK + row_of(dir, 64 * cc + et);
    bf16_t* mp = MG + eR * DM + mgc + 16 * epart;
    u32x4 pp0, pp1, pz0, pz1, pg0, pg1;
    pp0 = pp1 = pz0 = pz1 = pg0 = pg1 = (u32x4){0u, 0u, 0u, 0u};
    if (dir == 1) { const bf16_t* Ur = U + eR * NU; pp0 = *(const u32x4*)mp; pp1 = *(const u32x4*)(mp + 8); pz0 = *(const u32x4*)(Ur + zc + 16 * epart); pz1 = *(const u32x4*)(Ur + zc + 16 * epart + 8);
      if (MIX == 0) { pg0 = *(const u32x4*)(Ur + UC_MO + h * HD + 16 * epart); pg1 = *(const u32x4*)(Ur + UC_MO + h * HD + 16 * epart + 8); } }
    {
      const float cd = gts[384];
      bf16x8 Sb[4];
#pragma unroll
      for (int kb = 0; kb < 4; ++kb) Sb[kb] = pack2(S[2 * kb], S[2 * kb + 1]);
      f32x4 X[4];
      bf16x8 Xb[2], Wb[2];
      if (MIX == 2) {
        f32x4 KS[4];
#pragma unroll
        for (int tb = 0; tb < 4; ++tb) { KS[tb] = (f32x4){0.f, 0.f, 0.f, 0.f};
#pragma unroll
          for (int kb = 0; kb < 4; ++kb) KS[tb] = MFMA16(ld_perm(lds + L_K + (16 * tb + c16) * KSB, kb, g), Sb[kb], KS[tb]); }
#pragma unroll
        for (int tb = 0; tb < 4; ++tb) { const f32x4 al = *(const f32x4*)(gts + 128 + 16 * tb + 4 * g), be = *(const f32x4*)(gts + 256 + 16 * tb + 4 * g);
          const bf16x4 vv = tr_read(lds + L_V + trb + (16 * tb) * KSB + 32 * w);
#pragma unroll
          for (int r = 0; r < 4; ++r) KS[tb][r] = be[r] * (bf2f((bf16_t)vv[r]) - al[r] * KS[tb][r]); }
        const bf16x8 Rb0 = pack2(KS[0], KS[1]), Rb1 = pack2(KS[2], KS[3]);
#pragma unroll
        for (int tb = 0; tb < 4; ++tb) { X[tb] = (f32x4){0.f, 0.f, 0.f, 0.f};
          X[tb] = MFMA16(ld_perm(lds + L_T + (16 * tb + c16) * TSB, 0, g), Rb0, X[tb]); X[tb] = MFMA16(ld_perm(lds + L_T + (16 * tb + c16) * TSB, 1, g), Rb1, X[tb]); }
        Xb[0] = pack2(X[0], X[1]); Xb[1] = pack2(X[2], X[3]);
#pragma unroll
        for (int tb = 0; tb < 4; ++tb) { const f32x4 wv = *(const f32x4*)(gts + 192 + 16 * tb + 4 * g); X[tb] = X[tb] * wv; }
        Wb[0] = pack2(X[0], X[1]); Wb[1] = pack2(X[2], X[3]);
      } else {
#pragma unroll
        for (int ks = 0; ks < 2; ++ks) { Xb[ks] = tr_pair(lds + L_V + trb + (32 * ks) * KSB + 32 * w, 16 * KSB);
          const f32x4 w0 = *(const f32x4*)(gts + 192 + 32 * ks + 4 * g), w1 = *(const f32x4*)(gts + 192 + 32 * ks + 16 + 4 * g);
          f32x4 x0, x1;
#pragma unroll
          for (int j = 0; j < 4; ++j) { x0[j] = bf2f((bf16_t)Xb[ks][j]) * w0[j]; x1[j] = bf2f((bf16_t)Xb[ks][4 + j]) * w1[j]; }
          Wb[ks] = pack2(x0, x1); }
      }
#pragma unroll
      for (int tb = 0; tb < 4; ++tb) { f32x4 in = (f32x4){0.f, 0.f, 0.f, 0.f}, it = (f32x4){0.f, 0.f, 0.f, 0.f};
#pragma unroll
        for (int kb = 0; kb < 4; ++kb) in = MFMA16(ld_perm(lds + L_Q + (16 * tb + c16) * QSB, kb, g), Sb[kb], in);
#pragma unroll
        for (int ks = 0; ks < 2; ++ks) it = MFMA16(ld_perm(lds + L_AS + (16 * tb + c16) * TSB, ks, g), Xb[ks], it);
        const f32x4 al = *(const f32x4*)(gts + 128 + 16 * tb + 4 * g);
#pragma unroll
        for (int r = 0; r < 4; ++r) OSl[(16 * tb + 4 * g + r) * OSS + 16 * w + c16] = al[r] * in[r] + it[r]; }
#pragma unroll
      for (int hh = 0; hh < 2; ++hh) {
        bf16x8 kf[8];
#pragma unroll
        for (int ii = 0; ii < 4; ++ii) { const int i = 4 * hh + ii; kf[2 * ii] = tr_pair(lds + L_K + trk + 64 * (i >> 1) + 8 * (i & 1), 16 * KSB); kf[2 * ii + 1] = tr_pair(lds + L_K + trk + 32 * KSB + 64 * (i >> 1) + 8 * (i & 1), 16 * KSB); S[i] = S[i] * cd; }
        __builtin_amdgcn_sched_barrier(0);
#pragma unroll
        for (int ii = 0; ii < 4; ++ii) { const int i = 4 * hh + ii; S[i] = MFMA16(kf[2 * ii], Wb[0], S[i]); S[i] = MFMA16(kf[2 * ii + 1], Wb[1], S[i]); }
        __builtin_amdgcn_sched_barrier(0);
      }
      if (MIX == 0) {
        { const int dk = tid & 127, part = tid >> 7; float a = 0.f; const bf16_t* kp = (const bf16_t*)(lds + L_K) + (16 * part) * KS_ + pcol(dk);
#pragma unroll
          for (int k = 0; k < 16; ++k) a += gts[192 + 16 * part + k] * bf2f(kp[k * KS_]);
          NP[part * 128 + dk] = a; }
        { const float* no = nbuf + (st & 1) * 128; const bf16_t* qrow = (const bf16_t*)(lds + L_Q) + et * QS + 16 * epart; float ds = 0.f, as = 0.f;
#pragma unroll
          for (int k = 0; k < 16; ++k) ds += bf2f(qrow[k]) * no[unpcol(16 * epart + k)];
#pragma unroll
          for (int k = 0; k < 8; ++k) as += bf2f(ASl[et * TS + 8 * epart + k]);
          float den = gts[128 + et] * ds + as; den += __shfl_xor(den, 1); den += __shfl_xor(den, 2); den += __shfl_xor(den, 4);
          if (epart == 0) DEN[et] = den; }
      }
    }
    __syncthreads();
    if (st + 1 < 2 * nst) SCN_COMMIT(st + 1);
    if (MIX == 0 && tid < 128) { const float* no = nbuf + (st & 1) * 128; float* nn = nbuf + ((st + 1) & 1) * 128;
      nn[tid] = gts[384] * no[tid] + (NP[tid] + NP[128 + tid]) + (NP[256 + tid] + NP[384 + tid]); }
    {
      float o[16];
#pragma unroll
      for (int k4 = 0; k4 < 4; ++k4) { const f32x4 v = *(const f32x4*)(OSl + et * OSS + 16 * epart + 4 * k4); o[4 * k4] = v[0]; o[4 * k4 + 1] = v[1]; o[4 * k4 + 2] = v[2]; o[4 * k4 + 3] = v[3]; }
      if (MIX == 0) { const float sc = QSCALE / fmaxf(fabsf(DEN[et] * QSCALE), gts[320 + et]);
#pragma unroll
        for (int k = 0; k < 16; ++k) o[k] *= sc; }
      if (dir == 0) { u32x4 w0, w1;
#pragma unroll
        for (int k = 0; k < 4; ++k) { w0[k] = cvtpk(o[2 * k], o[2 * k + 1]); w1[k] = cvtpk(o[8 + 2 * k], o[8 + 2 * k + 1]); }
        *(u32x4*)mp = w0; *(u32x4*)(mp + 8) = w1;
      } else {
        float ss = 0.f;
#pragma unroll
        for (int k = 0; k < 8; ++k) { const unsigned pw = k < 4 ? pp0[k] : pp1[k - 4]; o[2 * k] += __uint_as_float(pw << 16); o[2 * k + 1] += __uint_as_float(pw & 0xffff0000u); }
        if (MIX == 0) {
#pragma unroll
          for (int k = 0; k < 8; ++k) { const unsigned gw = k < 4 ? pg0[k] : pg1[k - 4]; o[2 * k] *= __uint_as_float(gw << 16); o[2 * k + 1] *= __uint_as_float(gw & 0xffff0000u); } }
#pragma unroll
        for (int k = 0; k < 16; ++k) ss += o[k] * o[k];
        ss += __shfl_xor(ss, 1); ss += __shfl_xor(ss, 2); ss += __shfl_xor(ss, 4);
        const float rs = rsqrtf(ss * (1.f / HD) + EPS);
        u32x4 w0, w1;
#pragma unroll
        for (int k = 0; k < 8; ++k) { const unsigned zw = k < 4 ? pz0[k] : pz1[k - 4]; const float za = __uint_as_float(zw << 16), zb = __uint_as_float(zw & 0xffff0000u);
          const float ya = o[2 * k] * rs * HN[16 * epart + 2 * k] * za, yb = o[2 * k + 1] * rs * HN[16 * epart + 2 * k + 1] * zb;
          if (k < 4) w0[k] = cvtpk(ya, yb); else w1[k - 4] = cvtpk(ya, yb); }
        *(u32x4*)mp = w0; *(u32x4*)(mp + 8) = w1;
      }
    }
  }
  __syncthreads();
#undef SCN_ISSUE
#undef SCN_COMMIT
#undef SCN_DIR
#undef SCN_CC
}

namespace lean {
constexpr int LB = 64 * scn::KSB * 2 + 64 * scn::TSB;
constexpr int L_G = 2 * LB, L_END = L_G + 2 * 448 * 4;
}
template <int MIX>
DI void scan_lean(const Params& p, const int layer, const int b, const int h, const int dir, unsigned char* lds) {
  const int tid = opq_tid(), lane = tid & 63, w = __builtin_amdgcn_readfirstlane(tid >> 6), c16 = lane & 15, g = lane >> 4;
  const bf16_t* U = (const bf16_t*)(p.ws + WS_U);
  const bf16_t* src = MIX == 2 ? (const bf16_t*)(p.ws + WS_DQ) : U;
  constexpr int rstride = MIX == 2 ? 1536 : NU;
  const int koff = (MIX == 0 ? UC_MK : (MIX == 1 ? UC_RK : 512)) + h * HD, voff = (MIX == 0 ? UC_MV : (MIX == 1 ? UC_RV : 1024)) + h * HD;
  const bf16_t* TB = (const bf16_t*)(p.ws + WS_TB) + (size_t)((b * NH + h) * 2 + dir) * NCH * 4096;
  const int trb = (4 * g + (c16 >> 2)) * KSB + (c16 & 3) * 8, trk = (4 * g + (c16 >> 2)) * KSB + (c16 & 3) * 16;
  const int seq = ((MIX * NB + b) * NH + h) * 2 + dir;
  const int gi = layer * 8 + dir * 4 + h;
  f32x4 S[8];
#pragma unroll
  for (int i = 0; i < 8; ++i) S[i] = (f32x4){0.f, 0.f, 0.f, 0.f};
  float nreg = 0.f, m_state = 0.f;
  u32x4 kA[2], vA[2], tA; float gA0 = 0.f, gA1 = 0.f, gA2 = 0.f, gA3 = 0.f;
  tA = (u32x4){0u, 0u, 0u, 0u};
#define LN_ISSUE(cc_, K_, V_, T_, G0_, G1_, G2_, G3_) do {                                                                                \
    _Pragma("unroll") for (int i_ = 0; i_ < 2; ++i_) { const int idx_ = tid + 512 * i_, t_ = idx_ >> 4, pc_ = idx_ & 15;                 \
      const size_t R_ = (size_t)b * TOK + row_of(dir, 64 * (cc_) + t_); const bf16_t* rp_ = src + R_ * rstride + pc_ * 8;                   \
      K_[i_] = *(const u32x4*)(rp_ + koff); V_[i_] = *(const u32x4*)(rp_ + voff); }                                                         \
    if (MIX == 2) T_ = *(const u32x4*)(TB + (size_t)(cc_) * 4096 + (tid >> 3) * 64 + (tid & 7) * 8);                                       \
    if (w == 0 && MIX != 1) { const size_t R_ = (size_t)b * TOK + row_of(dir, 64 * (cc_) + lane); const float* gp_ = (const float*)(p.ws + WS_GP) + R_ * GPW; \
      if (MIX == 0) { gp_ += (dir * 4 + h) * 3; G0_ = gp_[0]; G1_ = gp_[1]; G2_ = gp_[2]; }                                                \
      else { const f32x4 q_ = *(const f32x4*)(gp_ + 24 + (dir * 4 + h) * 4); G0_ = q_[0]; G1_ = q_[1]; G2_ = q_[2]; G3_ = q_[3]; } } } while (0)
#define LN_COMMIT(cc_, buf_, K_, V_, T_, G0_, G1_, G2_, G3_) do { unsigned char* lb_ = lds + (buf_) * lean::LB; float* gt_ = (float*)(lds + lean::L_G) + (buf_) * 448; \
    _Pragma("unroll") for (int i_ = 0; i_ < 2; ++i_) { const int idx_ = tid + 512 * i_, t_ = idx_ >> 4, pc_ = idx_ & 15;                 \
      const int po_ = ((pc_ >> 2) * 32 + (pc_ & 1) * 16 + ((pc_ >> 1) & 1) * 4) * 2;                                                          \
      *(unsigned long long*)(lb_ + t_ * KSB + po_) = (unsigned long long)K_[i_][0] | ((unsigned long long)K_[i_][1] << 32); *(unsigned long long*)(lb_ + t_ * KSB + po_ + 16) = (unsigned long long)K_[i_][2] | ((unsigned long long)K_[i_][3] << 32); \
      *(u32x4*)(lb_ + 64 * KSB + t_ * KSB + pc_ * 16) = V_[i_]; }                                                                          \
    if (MIX == 2) *(u32x4*)(lb_ + 128 * KSB + (tid >> 3) * TSB + (tid & 7) * 16) = T_;                                                     \
    if (w == 0) { float alpha_, wv_, beta_ = 0.f, cd_;                                                                                     \
      if (MIX == 0) { if (((cc_) & 7) == 4 && lane == 0) ((float*)(p.ws + WS_CKN))[((size_t)seq * 8 + ((cc_) >> 3)) * 132 + 128] = m_state;  \
        const float run_ = fmaxf(m_state, G1_); const float run63_ = __shfl(run_, 63), bend_ = __shfl(G2_, 63);                               \
        alpha_ = __expf(m_state - run_); wv_ = __expf(G0_ - run63_); cd_ = __expf(m_state - run63_); m_state = bend_ + run63_; }              \
      else if (MIX == 1) { const float lg_ = p.r_lg[gi]; alpha_ = __expf(lg_ * (float)(lane + 1)); wv_ = __expf(lg_ * (float)(63 - lane)); cd_ = __expf(lg_ * 64.f); } \
      else { alpha_ = G1_; wv_ = G2_; beta_ = G3_; cd_ = __shfl(G1_, 63); }                                                                  \
      gt_[128 + lane] = alpha_; gt_[192 + lane] = wv_; gt_[256 + lane] = beta_; if (lane == 0) gt_[384] = cd_; } } while (0)
#define LN_STEP(cc_, buf_) do { const unsigned char* lb_ = lds + (buf_) * lean::LB; const float* gts = (const float*)(lds + lean::L_G) + (buf_) * 448;            \
    if (((cc_) & 7) == 4) { const int ck_ = (cc_) >> 3;                                                                                    \
      unsigned long long* cp_ = (unsigned long long*)(p.ws + WS_CK) + (((size_t)seq * 8 + ck_) * 8 + w) * 8 * 64 + lane;                     \
      _Pragma("unroll") for (int i_ = 0; i_ < 8; ++i_) cp_[i_ * 64] = (unsigned long long)cvtpk(S[i_][0], S[i_][1]) | ((unsigned long long)cvtpk(S[i_][2], S[i_][3]) << 32); \
      if (MIX == 0 && g == 0) ((float*)(p.ws + WS_CKN))[((size_t)seq * 8 + ck_) * 132 + 16 * w + c16] = nreg; }                              \
    const float cd = gts[384]; bf16x8 Wb[2];                                                                                               \
    if (MIX == 2) { bf16x8 Sb[4]; f32x4 KS[4], X[4];                                                                                       \
      _Pragma("unroll") for (int kb = 0; kb < 4; ++kb) Sb[kb] = pack2(S[2 * kb], S[2 * kb + 1]);                                            \
      _Pragma("unroll") for (int tb = 0; tb < 4; ++tb) { KS[tb] = (f32x4){0.f, 0.f, 0.f, 0.f};                                              \
        _Pragma("unroll") for (int kb = 0; kb < 4; ++kb) KS[tb] = MFMA16(ld_perm(lb_ + (16 * tb + c16) * KSB, kb, g), Sb[kb], KS[tb]); }     \
      _Pragma("unroll") for (int tb = 0; tb < 4; ++tb) { const f32x4 al = *(const f32x4*)(gts + 128 + 16 * tb + 4 * g), be = *(const f32x4*)(gts + 256 + 16 * tb + 4 * g); \
        const bf16x4 vv = tr_read(lb_ + 64 * KSB + trb + (16 * tb) * KSB + 32 * w);                                                         \
        _Pragma("unroll") for (int r = 0; r < 4; ++r) KS[tb][r] = be[r] * (bf2f((bf16_t)vv[r]) - al[r] * KS[tb][r]); }                      \
      const bf16x8 Rb0 = pack2(KS[0], KS[1]), Rb1 = pack2(KS[2], KS[3]);                                                                     \
      _Pragma("unroll") for (int tb = 0; tb < 4; ++tb) { X[tb] = (f32x4){0.f, 0.f, 0.f, 0.f};                                               \
        X[tb] = MFMA16(ld_perm(lb_ + 128 * KSB + (16 * tb + c16) * TSB, 0, g), Rb0, X[tb]); X[tb] = MFMA16(ld_perm(lb_ + 128 * KSB + (16 * tb + c16) * TSB, 1, g), Rb1, X[tb]); \
        const f32x4 wv = *(const f32x4*)(gts + 192 + 16 * tb + 4 * g); X[tb] = X[tb] * wv; }                                                \
      Wb[0] = pack2(X[0], X[1]); Wb[1] = pack2(X[2], X[3]);                                                                                  \
    } else {                                                                                                                               \
      _Pragma("unroll") for (int ks = 0; ks < 2; ++ks) { const bf16x8 xb = tr_pair(lb_ + 64 * KSB + trb + (32 * ks) * KSB + 32 * w, 16 * KSB); \
        const f32x4 w0 = *(const f32x4*)(gts + 192 + 32 * ks + 4 * g), w1 = *(const f32x4*)(gts + 192 + 32 * ks + 16 + 4 * g); f32x4 x0, x1;  \
        _Pragma("unroll") for (int j = 0; j < 4; ++j) { x0[j] = bf2f((bf16_t)xb[j]) * w0[j]; x1[j] = bf2f((bf16_t)xb[4 + j]) * w1[j]; }     \
        Wb[ks] = pack2(x0, x1); } }                                                                                                        \
    _Pragma("unroll") for (int hh = 0; hh < 2; ++hh) { bf16x8 kf[8];                                                                       \
      _Pragma("unroll") for (int ii = 0; ii < 4; ++ii) { const int i = 4 * hh + ii; kf[2 * ii] = tr_pair(lb_ + trk + 64 * (i >> 1) + 8 * (i & 1), 16 * KSB); kf[2 * ii + 1] = tr_pair(lb_ + trk + 32 * KSB + 64 * (i >> 1) + 8 * (i & 1), 16 * KSB); S[i] = S[i] * cd; } \
      __builtin_amdgcn_sched_barrier(0);                                                                                                   \
      _Pragma("unroll") for (int ii = 0; ii < 4; ++ii) { const int i = 4 * hh + ii; S[i] = MFMA16(kf[2 * ii], Wb[0], S[i]); S[i] = MFMA16(kf[2 * ii + 1], Wb[1], S[i]); } \
      __builtin_amdgcn_sched_barrier(0); }                                                                                                 \
    if (MIX == 0) { float a = 0.f; const bf16_t* kp = (const bf16_t*)lb_ + (16 * g) * KS_ + pcol(16 * w + c16);                             \
      _Pragma("unroll") for (int k = 0; k < 16; ++k) a += gts[192 + 16 * g + k] * bf2f(kp[k * KS_]);                                        \
      a += __shfl_xor(a, 16); a += __shfl_xor(a, 32); nreg = cd * nreg + a; } } while (0)

  LN_ISSUE(0, kA, vA, tA, gA0, gA1, gA2, gA3);
  LN_COMMIT(0, 0, kA, vA, tA, gA0, gA1, gA2, gA3);
  LN_ISSUE(1, kA, vA, tA, gA0, gA1, gA2, gA3);
  for (int cc = 0; cc < NCH; cc += 2) {
    __syncthreads();
    LN_STEP(cc, 0);
    LN_COMMIT(cc + 1, 1, kA, vA, tA, gA0, gA1, gA2, gA3);
    if (cc + 2 < NCH) LN_ISSUE(cc + 2, kA, vA, tA, gA0, gA1, gA2, gA3);
    __syncthreads();
    LN_STEP(cc + 1, 1);
    if (cc + 2 < NCH) { LN_COMMIT(cc + 2, 0, kA, vA, tA, gA0, gA1, gA2, gA3); if (cc + 3 < NCH) LN_ISSUE(cc + 3, kA, vA, tA, gA0, gA1, gA2, gA3); }
  }
  __syncthreads();
#undef LN_ISSUE
#undef LN_COMMIT
#undef LN_STEP
}

}

namespace pdn {
constexpr int CBS = 520;
constexpr int L_CB = 0, L_KK = 64 * CBS * 2, L_GL = L_KK + 4 * 64 * 64 * 4, L_END = L_GL + 2 * 8 * 64 * 4;
template <int DIR> DI scn::f32x4 ld_l4(const float* kk, const int t, const int q) {
  if (DIR == 0) return *(const scn::f32x4*)(kk + t * 64 + 4 * q);
  const scn::f32x4 v = *(const scn::f32x4*)(kk + (63 - t) * 64 + 60 - 4 * q); return (scn::f32x4){v[3], v[2], v[1], v[0]};
}
template <int DIR> DI void solve_tri(const float* kk, const int lane, float (&Tc)[64]) {
#pragma unroll
  for (int I = 0; I < 4; ++I) {
    float acc[16];
#pragma unroll
    for (int r = 0; r < 16; ++r) acc[r] = (lane == 16 * I + r) ? 1.f : 0.f;
#pragma unroll
    for (int q = 0; q < 4 * I; ++q) {
#pragma unroll
      for (int r = 0; r < 16; ++r) { const scn::f32x4 v = ld_l4<DIR>(kk, 16 * I + r, q); acc[r] -= v[0] * Tc[4 * q]; acc[r] -= v[1] * Tc[4 * q + 1]; acc[r] -= v[2] * Tc[4 * q + 2]; acc[r] -= v[3] * Tc[4 * q + 3]; }
      asm volatile("" ::: "memory"); }
    scn::f32x4 cur[4], nxt[4];
#pragma unroll
    for (int qq = 0; qq < 4; ++qq) { cur[qq] = ld_l4<DIR>(kk, 16 * I, 4 * I + qq); nxt[qq] = cur[qq]; }
#pragma unroll
    for (int r = 0; r < 16; ++r) {
      if (r < 15) {
#pragma unroll
        for (int qq = 0; qq < 4; ++qq) if (4 * qq < r + 1) nxt[qq] = ld_l4<DIR>(kk, 16 * I + r + 1, 4 * I + qq); }
      float a0 = acc[r], a1 = 0.f;
#pragma unroll
      for (int sp = 0; sp < r; ++sp) { const float lv = cur[sp >> 2][sp & 3]; if (sp & 1) a1 -= lv * Tc[16 * I + sp]; else a0 -= lv * Tc[16 * I + sp]; }
      float res = a0 + a1;
      asm volatile("" : "+v"(res) :: "memory");
      Tc[16 * I + r] = res;
#pragma unroll
      for (int qq = 0; qq < 4; ++qq) cur[qq] = nxt[qq];
    }
  }
}
DI void prep_unit(const Params& p, const int layer, const int b, const int cc, const int mode, unsigned char* lds) {
  const int tid = opq_tid(), lane = tid & 63, w = __builtin_amdgcn_readfirstlane(tid >> 6), c16 = lane & 15, g = lane >> 4;
  const bf16_t* U = (const bf16_t*)(p.ws + WS_U); bf16_t* DQ = (bf16_t*)(p.ws + WS_DQ);
  bf16_t* CB = (bf16_t*)(lds + L_CB); float* KK = (float*)(lds + L_KK); float* GL = (float*)(lds + L_GL);
  const size_t R0 = (size_t)b * TOK + 64 * cc; const bool isctx = cc < 4; const int pos0 = isctx ? 64 * cc : 64 * (cc - 4), len = isctx ? CTX : SEQ;
  const float* cw = p.conv_w + (size_t)layer * 5 * 1536;
  {
    const int part = mode == 0 ? 1 : (mode == 1 ? 0 : 2);
    {
      typedef float f32x2 __attribute__((ext_vector_type(2)));
      const int cp = tid & 255, th = tid >> 8, ch = part * 512 + 2 * cp; const bf16_t* up = U + (R0 + 32 * th) * NU + UC_DQ + ch;
      f32x2 cwv[5];
#pragma unroll
      for (int j = 0; j < 5; ++j) { const float2 q = *(const float2*)(cw + j * 1536 + ch); cwv[j] = (f32x2){q.x, q.y}; }
      unsigned xr[36];
#pragma unroll
      for (int i = 0; i < 36; ++i) { const int pp = pos0 + 32 * th - 2 + i; xr[i] = (pp >= 0 && pp < len) ? *(const unsigned*)(up + (ptrdiff_t)(i - 2) * NU) : 0u; }
#pragma unroll
      for (int t = 0; t < 32; ++t) { f32x2 a = (f32x2){0.f, 0.f};
#pragma unroll
        for (int j = 0; j < 5; ++j) { const f32x2 x = (f32x2){__uint_as_float(xr[t + j] << 16), __uint_as_float(xr[t + j] & 0xffff0000u)}; a += x * cwv[j]; }
        *(unsigned*)(CB + (32 * th + t) * CBS + 2 * cp) = scn::cvtpk(siluf(a.x), siluf(a.y)); } }
    __syncthreads();
    { const int t = tid >> 3, p8 = tid & 7;
      scn::u32x4 v[8]; float ss = 0.f;
#pragma unroll
      for (int k = 0; k < 8; ++k) { v[k] = *(const scn::u32x4*)(CB + t * CBS + 64 * p8 + 8 * k);
#pragma unroll
        for (int e = 0; e < 4; ++e) { const float x0 = __uint_as_float(v[k][e] << 16), x1 = __uint_as_float(v[k][e] & 0xffff0000u); ss += x0 * x0 + x1 * x1; } }
      if (part < 2) { ss += __shfl_xor(ss, 1); float rs = rsqrtf(ss + EPS); if (part == 0) rs *= QSCALE;
#pragma unroll
        for (int k = 0; k < 8; ++k)
#pragma unroll
          for (int e = 0; e < 4; ++e) { const float x0 = __uint_as_float(v[k][e] << 16) * rs, x1 = __uint_as_float(v[k][e] & 0xffff0000u) * rs; v[k][e] = scn::cvtpk(x0, x1); } }
      bf16_t* dp = DQ + (R0 + t) * 1536 + part * 512 + 64 * p8;
#pragma unroll
      for (int k = 0; k < 8; ++k) *(scn::u32x4*)(dp + 8 * k) = v[k];
      if (part == 1) {
#pragma unroll
        for (int k = 0; k < 8; ++k) *(scn::u32x4*)(CB + t * CBS + 64 * p8 + 8 * k) = v[k]; } }
    __syncthreads();
  }
  if (mode != 0) return;
  { const int tb = w >> 1;
#pragma unroll
    for (int head = 0; head < 4; ++head)
#pragma unroll
      for (int q2 = 0; q2 < 2; ++q2) { const int sb = 2 * (w & 1) + q2; scn::f32x4 acc = (scn::f32x4){0.f, 0.f, 0.f, 0.f};
#pragma unroll
        for (int kb = 0; kb < 4; ++kb) { const scn::bf16x8 a = *(const scn::bf16x8*)((const unsigned char*)CB + (16 * tb + c16) * (CBS * 2) + head * 256 + kb * 64 + g * 16), bb = *(const scn::bf16x8*)((const unsigned char*)CB + (16 * sb + c16) * (CBS * 2) + head * 256 + kb * 64 + g * 16);
          acc = MFMA16(a, bb, acc); }
#pragma unroll
        for (int r = 0; r < 4; ++r) KK[head * 4096 + (16 * tb + 4 * g + r) * 64 + 16 * sb + c16] = acc[r]; } }
  __syncthreads();
  {
    const int hh = w >> 1, dir = w & 1; const int gi = layer * 8 + dir * 4 + hh;
    float* gl = GL + w * 128; float* bl = gl + 64; float* kk = KK + hh * 4096;
    { const int tt = dir == 0 ? lane : 63 - lane; const bf16_t* up = U + (R0 + tt) * NU + dir * 4 + hh; float* gp = (float*)(p.ws + WS_GP) + (R0 + tt) * GPW;
      const float la = -__expf(p.a_log[gi]) * softplusf(bf2f(up[UC_DA]) + p.dt_bias[gi]); const float gg = scn::wave_psum(la, lane); const float bt = sigmoidf(bf2f(up[UC_DB])); const float g63 = __shfl(gg, 63);
      gl[lane] = gg; bl[lane] = bt;
      *(scn::f32x4*)(gp + 24 + (dir * 4 + hh) * 4) = (scn::f32x4){gg, __expf(gg), __expf(g63 - gg), bt};
      const float li = bf2f(up[UC_MI]) + p.m_ib[gi], lf = logsigmoidf(bf2f(up[UC_MF]) + p.m_fb[gi]); const float bc = scn::wave_psum(lf, lane); const float a = li - bc; const float cm = scn::wave_pmax(a, lane);
      float* gm = gp + (dir * 4 + hh) * 3; gm[0] = a; gm[1] = cm; gm[2] = bc; }
    { const float gs = gl[lane];
#pragma unroll
      for (int t0 = 0; t0 < 64; t0 += 16) { float kv[16];
#pragma unroll
        for (int r = 0; r < 16; ++r) { const int t = t0 + r; kv[r] = kk[dir == 0 ? t * 64 + lane : (63 - t) * 64 + 63 - lane]; }
#pragma unroll
        for (int r = 0; r < 16; ++r) { const int t = t0 + r; kv[r] = bl[t] * __expf(gl[t] - gs) * kv[r]; }
#pragma unroll
        for (int r = 0; r < 16; ++r) { const int t = t0 + r; if (t > 0 && lane < t) kk[dir == 0 ? t * 64 + lane : (63 - t) * 64 + 63 - lane] = kv[r]; }
        asm volatile("" ::: "memory"); } }
    float Tc[64];
    if (dir == 0) solve_tri<0>(kk, lane, Tc); else solve_tri<1>(kk, lane, Tc);
    const int cscan = dir == 0 ? cc : (isctx ? 3 - cc : 71 - cc);
    bf16_t* tb = (bf16_t*)(p.ws + WS_TB) + ((size_t)((b * NH + hh) * 2 + dir) * scn::NCH + cscan) * 4096;
#pragma unroll
    for (int t = 0; t < 64; ++t) tb[t * 64 + scn::pcol(lane)] = f2bf(Tc[t]);
  }
  __syncthreads();
}
}
constexpr int LDS_CTL = 136192;
static_assert(pdn::L_END <= LDS_CTL && scn::L_END <= LDS_CTL && scn::lean::L_END <= LDS_CTL && pg8::STAGE_BYTES <= LDS_CTL, "LDS map");


namespace attn {
using bf16 = unsigned short;
constexpr int   D = 128, NW = 8, QBLK = 32, KVBLK = 64;
constexpr float SCALE = 0.088388347648318440f;
constexpr float THR = 8.f;
constexpr int SDEPTH = 2;
constexpr int LDQ = NU, LDK = NU, LDZ = NU, LDO = DM;
constexpr size_t SHM_V = KVBLK * D * 2, SHM_K = KVBLK * D * 2, SHM_ATTN = 2 * SHM_V + 2 * SHM_K + NW * 64 * 4;
using bf16x8 = __attribute__((ext_vector_type(8))) short;
using s16x4  = __attribute__((ext_vector_type(4))) short;
using f32x16 = __attribute__((ext_vector_type(16))) float;
using f32x8  = __attribute__((ext_vector_type(8))) float;
using u32x4  = __attribute__((ext_vector_type(4))) unsigned;
#define KSWZ(row, colB) ((row) * 256 + ((colB) ^ (((row) & 7) << 4)))
#define SBAR() __builtin_amdgcn_sched_barrier(0)
__device__ __forceinline__ int crow(int r, int hi) { return (r & 3) + 8 * (r >> 2) + 4 * hi; }
__device__ __forceinline__ unsigned cvtpk(float lo, float hi) {
  unsigned r; asm volatile("v_cvt_pk_bf16_f32 %0, %1, %2" : "=v"(r) : "v"(lo), "v"(hi)); return r;
}
template <typename TIn> struct Stage;
template <> struct Stage<bf16>  { using T = bf16x8;
  __device__ static __forceinline__ T ld8(const bf16* p) { return *reinterpret_cast<const bf16x8*>(p); }
  __device__ static __forceinline__ bf16x8 tobf(T x) { return x; } };
template <> struct Stage<float> { using T = f32x8;
  __device__ static __forceinline__ T ld8(const float* p) { return *reinterpret_cast<const f32x8*>(p); }
  __device__ static __forceinline__ bf16x8 tobf(T x) {
    u32x4 w = {cvtpk(x[0], x[1]), cvtpk(x[2], x[3]), cvtpk(x[4], x[5]), cvtpk(x[6], x[7])}; return *reinterpret_cast<bf16x8*>(&w); } };

__device__ __forceinline__ void partialSM(f32x16& p0, f32x16& p1, float& m_reg, float& mn, float& alpha) {
  constexpr float C = SCALE * 1.4426950408889634f;
  float pmax = p0[0]; for (int r = 1; r < 16; ++r) pmax = fmaxf(pmax, p0[r]); for (int r = 0; r < 16; ++r) pmax = fmaxf(pmax, p1[r]);
  { auto rr = __builtin_amdgcn_permlane32_swap(__float_as_uint(pmax), __float_as_uint(pmax), false, false);
    pmax = fmaxf(__uint_as_float(rr[0]), __uint_as_float(rr[1])); }
  if (__builtin_expect(__all(pmax - m_reg <= THR / SCALE), 1)) { mn = m_reg; alpha = 1.f; }
  else { mn = fmaxf(m_reg, pmax); alpha = __builtin_amdgcn_exp2f((m_reg - mn) * C); m_reg = mn; }
  float mnC = -mn * C;
  for (int r = 0; r < 16; ++r) p0[r] = fmaf(p0[r], C, mnC); for (int r = 0; r < 16; ++r) p1[r] = fmaf(p1[r], C, mnC);
  for (int r = 0; r < 16; ++r) p0[r] = __builtin_amdgcn_exp2f(p0[r]);
}
__device__ __forceinline__ void finishSM(f32x16& p0, f32x16& p1, float alpha, float& l_reg, bf16x8& pa0, bf16x8& pa1, bf16x8& pa2, bf16x8& pa3) {
  for (int r = 0; r < 16; ++r) p1[r] = __builtin_amdgcn_exp2f(p1[r]);
  float ps = 0; for (int r = 0; r < 16; ++r) ps += p0[r]; for (int r = 0; r < 16; ++r) ps += p1[r];
  { auto rr = __builtin_amdgcn_permlane32_swap(__float_as_uint(ps), __float_as_uint(ps), false, false);
    ps = __uint_as_float(rr[0]) + __uint_as_float(rr[1]); }
  l_reg = l_reg * alpha + ps;
#define PK4(P, BASE, OUT) do { unsigned a0 = cvtpk(P[BASE + 0], P[BASE + 1]), a1 = cvtpk(P[BASE + 2], P[BASE + 3]);   \
    unsigned b0 = cvtpk(P[BASE + 4], P[BASE + 5]), b1 = cvtpk(P[BASE + 6], P[BASE + 7]);                              \
    auto r0 = __builtin_amdgcn_permlane32_swap(a0, b0, false, false); auto r1 = __builtin_amdgcn_permlane32_swap(a1, b1, false, false); \
    u32x4 w = {r0[0], r1[0], r0[1], r1[1]}; OUT = *reinterpret_cast<bf16x8*>(&w); } while (0)
  PK4(p0, 0, pa0); PK4(p0, 8, pa1); PK4(p1, 0, pa2); PK4(p1, 8, pa3);
#undef PK4
}
__device__ __forceinline__ void qkt(f32x16& p0, f32x16& p1, const bf16* Ks, const bf16x8* qr, int r32, int hi) {
  p0 = f32x16{}; p1 = f32x16{};
  for (int d0 = 0; d0 < 8; ++d0) { int cb = (d0 * 16 + hi * 8) * 2;
    bf16x8 b0 = *reinterpret_cast<const bf16x8*>((const char*)Ks + KSWZ(r32, cb));
    bf16x8 b1 = *reinterpret_cast<const bf16x8*>((const char*)Ks + KSWZ(32 + r32, cb));
    p0 = __builtin_amdgcn_mfma_f32_32x32x16_bf16(b0, qr[d0], p0, 0, 0, 0);
    p1 = __builtin_amdgcn_mfma_f32_32x32x16_bf16(b1, qr[d0], p1, 0, 0, 0); }
}
__device__ __forceinline__ int v_st(int k, int c) { const int kk = (k & ~0xC) | ((k & 4) << 1) | ((k & 8) >> 1); return ((kk >> 3) * 4 + (c >> 5)) * 512 + ((kk & 7) * 32 + (c & 31)) * 2; }
__device__ __forceinline__ int v_rd_base(int lane) { return ((lane & 3) << 3) | (((lane >> 2) & 3) << 6) | (((lane >> 4) & 1) << 5) | (((lane >> 5) & 1) << 8); }
constexpr int v_rd_off(int d0, int ks, int half) { return d0 * 512 + ks * 4096 + half * 2048; }
template <int OFF> __device__ __forceinline__ s16x4 tr_read(int vb) {
  s16x4 r; asm volatile("ds_read_b64_tr_b16 %0, %1 offset:%2" : "=&v"(r) : "v"(vb), "i"(OFF) : "memory"); return r;
}
template <int D0> __device__ __forceinline__ void pv_one(f32x16& od, int vb, bf16x8 pa0, bf16x8 pa1, bf16x8 pa2, bf16x8 pa3) {
  const s16x4 l0 = tr_read<v_rd_off(D0, 0, 0)>(vb), h0 = tr_read<v_rd_off(D0, 0, 1)>(vb), l1 = tr_read<v_rd_off(D0, 1, 0)>(vb), h1 = tr_read<v_rd_off(D0, 1, 1)>(vb);
  const s16x4 l2 = tr_read<v_rd_off(D0, 2, 0)>(vb), h2 = tr_read<v_rd_off(D0, 2, 1)>(vb), l3 = tr_read<v_rd_off(D0, 3, 0)>(vb), h3 = tr_read<v_rd_off(D0, 3, 1)>(vb);
  asm volatile("s_waitcnt lgkmcnt(0)" ::: "memory"); SBAR();
#define PK(L, H) (bf16x8){L[0], L[1], L[2], L[3], H[0], H[1], H[2], H[3]}
  od = __builtin_amdgcn_mfma_f32_32x32x16_bf16(pa0, PK(l0, h0), od, 0, 0, 0);
  od = __builtin_amdgcn_mfma_f32_32x32x16_bf16(pa1, PK(l1, h1), od, 0, 0, 0);
  od = __builtin_amdgcn_mfma_f32_32x32x16_bf16(pa2, PK(l2, h2), od, 0, 0, 0);
  od = __builtin_amdgcn_mfma_f32_32x32x16_bf16(pa3, PK(l3, h3), od, 0, 0, 0);
#undef PK
}
__device__ __forceinline__ void pv_d0(f32x16* o, int vb, bf16x8 pa0, bf16x8 pa1, bf16x8 pa2, bf16x8 pa3) {
  pv_one<0>(o[0], vb, pa0, pa1, pa2, pa3); pv_one<1>(o[1], vb, pa0, pa1, pa2, pa3); pv_one<2>(o[2], vb, pa0, pa1, pa2, pa3); pv_one<3>(o[3], vb, pa0, pa1, pa2, pa3);
}
template <typename TQ>
__device__ __forceinline__ void attn_dense_body(const TQ* __restrict__ Qb, const bf16* __restrict__ Kh, const bf16* __restrict__ Vh,
                                                const bf16* __restrict__ Zb, bf16* __restrict__ Ob, int seq, char* lds,
                                                const float* __restrict__ qw = nullptr, const float* __restrict__ ropet = nullptr, const int pos0 = -1) {
  using St = Stage<bf16>; using SQ = Stage<TQ>;
  const int tid = opq_tid(), wid = __builtin_amdgcn_readfirstlane(tid >> 6), lane = tid & 63, r32 = lane & 31, hi = lane >> 5;
  bf16* V_lds = (bf16*)lds; bf16* K_lds = (bf16*)(lds + 2 * SHM_V);
  float* ws = (float*)(lds + 2 * SHM_V + 2 * SHM_K) + wid * 64; float* li_l = ws; float* al_l = ws + 32;
  float m_reg = -1e30f, l_reg = 0; f32x16 o[4] = {}; bf16x8 qr[8];
  const TQ* Qw = Qb + (long)(wid * QBLK + r32) * LDQ + hi * 8;
#pragma unroll
  for (int d0 = 0; d0 < 8; ++d0) qr[d0] = SQ::tobf(SQ::ld8(Qw + d0 * 16));
  if (qw) {
    float ss = 0.f;
#pragma unroll
    for (int d0 = 0; d0 < 8; ++d0)
#pragma unroll
      for (int j = 0; j < 8; ++j) { const float x = __uint_as_float(((unsigned)(unsigned short)qr[d0][j]) << 16); ss += x * x; }
    ss += __shfl_xor(ss, 32);
    const float rs = rsqrtf(ss * (1.f / D) + 1e-6f);
    const int pos = pos0 + wid * QBLK + r32;
#pragma unroll
    for (int ax = 0; ax < 2; ++ax)
#pragma unroll
      for (int e = 0; e < 2; ++e) {
        const int dA = 16 * (4 * ax + e) + 8 * hi, i0 = 16 * e + 8 * hi;
        float cs[8], sn[8], wa[8], wb[8];
        { const float4 a0 = *(const float4*)(qw + dA), a1 = *(const float4*)(qw + dA + 4), b0 = *(const float4*)(qw + dA + 32), b1 = *(const float4*)(qw + dA + 36);
          wa[0] = a0.x; wa[1] = a0.y; wa[2] = a0.z; wa[3] = a0.w; wa[4] = a1.x; wa[5] = a1.y; wa[6] = a1.z; wa[7] = a1.w;
          wb[0] = b0.x; wb[1] = b0.y; wb[2] = b0.z; wb[3] = b0.w; wb[4] = b1.x; wb[5] = b1.y; wb[6] = b1.z; wb[7] = b1.w; }
        if (pos0 >= 0) { const int pp = ax == 0 ? (pos >> 6) : (pos & 63); const float* ct = ropet + pp * 32 + i0; const float* st = ct + 64 * 32;
          const float4 c0 = *(const float4*)ct, c1 = *(const float4*)(ct + 4), s0 = *(const float4*)st, s1 = *(const float4*)(st + 4);
          cs[0] = c0.x; cs[1] = c0.y; cs[2] = c0.z; cs[3] = c0.w; cs[4] = c1.x; cs[5] = c1.y; cs[6] = c1.z; cs[7] = c1.w;
          sn[0] = s0.x; sn[1] = s0.y; sn[2] = s0.z; sn[3] = s0.w; sn[4] = s1.x; sn[5] = s1.y; sn[6] = s1.z; sn[7] = s1.w; }
        else {
#pragma unroll
          for (int j = 0; j < 8; ++j) { cs[j] = 1.f; sn[j] = 0.f; } }
        float o1[8], o2[8];
#pragma unroll
        for (int j = 0; j < 8; ++j) { const float t1 = __uint_as_float(((unsigned)(unsigned short)qr[4 * ax + e][j]) << 16) * rs * wa[j], t2 = __uint_as_float(((unsigned)(unsigned short)qr[4 * ax + e + 2][j]) << 16) * rs * wb[j];
          o1[j] = t1 * cs[j] - t2 * sn[j]; o2[j] = t2 * cs[j] + t1 * sn[j]; }
        { u32x4 w1 = {cvtpk(o1[0], o1[1]), cvtpk(o1[2], o1[3]), cvtpk(o1[4], o1[5]), cvtpk(o1[6], o1[7])}, w2 = {cvtpk(o2[0], o2[1]), cvtpk(o2[2], o2[3]), cvtpk(o2[4], o2[5]), cvtpk(o2[6], o2[7])};
          qr[4 * ax + e] = *reinterpret_cast<bf16x8*>(&w1); qr[4 * ax + e + 2] = *reinterpret_cast<bf16x8*>(&w2); }
      }
  }
  const int sr = tid >> 4, sc = (tid & 15) * 8, vst0 = v_st(sr, sc), vst1 = v_st(32 + sr, sc);
  const int vb0 = (int)(uintptr_t)V_lds + v_rd_base(lane);
  struct { typename St::T vs0, vs1, ks0, ks1; } sr_[SDEPTH];
#define SLOAD(i, k0) do { sr_[i].vs0 = St::ld8(&Vh[(long)((k0) + sr) * LDK + sc]); sr_[i].vs1 = St::ld8(&Vh[(long)((k0) + 32 + sr) * LDK + sc]); \
    sr_[i].ks0 = St::ld8(&Kh[(long)((k0) + sr) * LDK + sc]); sr_[i].ks1 = St::ld8(&Kh[(long)((k0) + 32 + sr) * LDK + sc]); } while (0)
#define SWRITE(b, i) do { *(bf16x8*)((char*)V_lds + (b) * SHM_V + vst0) = St::tobf(sr_[i].vs0);          \
    *(bf16x8*)((char*)V_lds + (b) * SHM_V + vst1) = St::tobf(sr_[i].vs1); int kc = sc * 2;               \
    *(bf16x8*)((char*)K_lds + (b) * SHM_K + KSWZ(sr, kc)) = St::tobf(sr_[i].ks0);                       \
    *(bf16x8*)((char*)K_lds + (b) * SHM_K + KSWZ(32 + sr, kc)) = St::tobf(sr_[i].ks1); } while (0)
#define SWAIT() do { if constexpr (SDEPTH == 2) asm volatile("s_waitcnt vmcnt(4)" ::: "memory"); else asm volatile("s_waitcnt vmcnt(0)" ::: "memory"); } while (0)
#define RESC(a) do { if (__any((a) < 1.f)) { if (hi == 0) al_l[r32] = (a); asm volatile("s_waitcnt lgkmcnt(0)" ::: "memory"); \
    for (int d = 0; d < 4; ++d) for (int r = 0; r < 16; ++r) o[d][r] *= al_l[crow(r, hi)]; } } while (0)
  f32x16 pA0, pA1, pB0, pB1; float mnA, mnB, alA, alB; bf16x8 pa0, pa1, pa2, pa3; const int NT = seq / KVBLK;
  constexpr int SE = 0, SO = SDEPTH - 1;
  SLOAD(SE, 0); asm volatile("s_waitcnt vmcnt(0)" ::: "memory"); SWRITE(0, SE); __syncthreads();
  qkt(pA0, pA1, K_lds, qr, r32, hi); partialSM(pA0, pA1, m_reg, mnA, alA);
  SLOAD(SO, KVBLK); if constexpr (SDEPTH == 2) { if (2 < NT) SLOAD(SE, 2 * KVBLK); }
  SWAIT(); SWRITE(1, SO); __syncthreads();
  for (int j = 1; j + 1 < NT; j += 2) {
    SBAR(); qkt(pB0, pB1, (bf16*)((char*)K_lds + SHM_K), qr, r32, hi);
    finishSM(pA0, pA1, alA, l_reg, pa0, pa1, pa2, pa3); SBAR();
    SLOAD(SO, (j + SDEPTH) * KVBLK); SBAR();
    pv_d0(o, vb0, pa0, pa1, pa2, pa3); partialSM(pB0, pB1, m_reg, mnB, alB);
    __syncthreads(); SWAIT(); SWRITE(0, SE);
    RESC(alB); __syncthreads();
    SBAR(); qkt(pA0, pA1, K_lds, qr, r32, hi);
    finishSM(pB0, pB1, alB, l_reg, pa0, pa1, pa2, pa3); SBAR();
    if (SDEPTH == 1 || j + 3 < NT) SLOAD(SE, (j + 1 + SDEPTH) * KVBLK); SBAR();
    pv_d0(o, vb0 + (int)SHM_V, pa0, pa1, pa2, pa3); partialSM(pA0, pA1, m_reg, mnA, alA);
    __syncthreads(); SWAIT(); SWRITE(1, SO);
    RESC(alA); __syncthreads();
  }
  SBAR(); qkt(pB0, pB1, (bf16*)((char*)K_lds + SHM_K), qr, r32, hi);
  finishSM(pA0, pA1, alA, l_reg, pa0, pa1, pa2, pa3); SBAR();
  pv_d0(o, vb0, pa0, pa1, pa2, pa3); partialSM(pB0, pB1, m_reg, mnB, alB);
  __syncthreads(); RESC(alB);
  finishSM(pB0, pB1, alB, l_reg, pa0, pa1, pa2, pa3); SBAR();
  pv_d0(o, vb0 + (int)SHM_V, pa0, pa1, pa2, pa3);
  if (hi == 0) li_l[r32] = l_reg; asm volatile("s_waitcnt lgkmcnt(0)" ::: "memory");
  float rli[16];
#pragma unroll
  for (int r = 0; r < 16; ++r) rli[r] = __builtin_amdgcn_rcpf(li_l[crow(r, hi)]);
  __syncthreads();
  asm volatile("" ::: "memory");
  { bf16* stg = (bf16*)lds + wid * (QBLK * D);
#pragma unroll
    for (int r = 0; r < 16; ++r) { const int orow = crow(r, hi);
#pragma unroll
      for (int d0 = 0; d0 < 4; ++d0) stg[orow * D + d0 * 32 + r32] = f2bf(o[d0][r] * rli[r]); }
    asm volatile("s_waitcnt lgkmcnt(0)" ::: "memory");
    bf16* Ow = Ob + (long)(wid * QBLK) * LDO; const bf16* Zw = Zb + (long)(wid * QBLK) * LDZ;
    int ln = lane; asm volatile("" : "+v"(ln));
#pragma unroll
    for (int i = 0; i < 8; ++i) { const int row = i * 4 + (ln >> 4), ch = ln & 15;
      const u32x4 ov = *(const u32x4*)(stg + row * D + ch * 8); const u32x4 zv = *(const u32x4*)(Zw + (long)row * LDZ + ch * 8); u32x4 w;
#pragma unroll
      for (int j = 0; j < 4; ++j) { const float z0 = __uint_as_float(zv[j] << 16), z1 = __uint_as_float(zv[j] & 0xffff0000u), a0 = __uint_as_float(ov[j] << 16), a1 = __uint_as_float(ov[j] & 0xffff0000u);
        w[j] = cvtpk(a0 * z0, a1 * z1); }
      *(u32x4*)(Ow + (long)row * LDO + ch * 8) = w; } }
  __syncthreads();
#undef SLOAD
#undef SWRITE
#undef SWAIT
#undef RESC
}

}

__device__ __forceinline__ void attn_unit(const Params& p, const int layer, int u, char* lds) {
  const bf16_t* U = (const bf16_t*)(p.ws + WS_U); bf16_t* MG = (bf16_t*)(p.ws + WS_HB);
  int b, h, t0, seq;
  if (u < 256) { b = u >> 6; h = (u >> 4) & 3; t0 = CTX + (u & 15) * 256; seq = TOK; } else { b = (u - 256) >> 2; h = (u - 256) & 3; t0 = 0; seq = CTX; }
  const size_t R0 = (size_t)b * TOK + t0, K0 = (size_t)b * TOK; const int kvh = h >> 1;
  attn::attn_dense_body<attn::bf16>(U + R0 * NU + UC_AQ + h * HD, U + K0 * NU + UC_AK + kvh * HD, U + K0 * NU + UC_AV + kvh * HD, U + R0 * NU + UC_AZ + h * HD, MG + R0 * DM + MG_A + h * HD, seq, lds,
                                    p.qn_w + layer * HD, (const float*)(p.ws + WS_ROPE), u < 256 ? (u & 15) * 256 : -1);
}

#define LAS __attribute__((address_space(3)))
#define XB_TMO      128
#define XB_XCNT(j)  (256  + 64 * (j))
#define XB_XSUB(j)  (1280 + 64 * (j))
#define XB_XGEN(j)  (2304 + 64 * (j))
#define XB_TOP      3328
#define XB_TOPGEN   3392
#define XCD_BAR_WORDS 3456
#define XB_SPIN_CAP (1u << 18)

__device__ __forceinline__ unsigned xb_ld(unsigned* p)              { return __hip_atomic_load(p, __ATOMIC_RELAXED, __HIP_MEMORY_SCOPE_AGENT); }
__device__ __forceinline__ unsigned xb_add(unsigned* p, unsigned v) { return __hip_atomic_fetch_add(p, v, __ATOMIC_RELAXED, __HIP_MEMORY_SCOPE_AGENT); }
__device__ __forceinline__ unsigned xb_xcc_id() { return (unsigned)__builtin_amdgcn_s_getreg((3 << 11) | 20) & 0xFu; }
#define XB_SPIN(cond, bar) do { unsigned _sp = 0; while (cond) { __builtin_amdgcn_s_sleep(1); \
    if ((++_sp & 255u) == 0u) { if (xb_ld(&(bar)[XB_TMO])) break; if (_sp > XB_SPIN_CAP) { atomicAdd(&(bar)[XB_TMO], 1u); break; } } } } while (0)

struct XcdBarrier {
    unsigned* bar; unsigned x;
    volatile LAS unsigned* st;
};

__device__ __forceinline__ XcdBarrier xcd_barrier_post(unsigned* bar, volatile LAS unsigned* st) {
    XcdBarrier b; b.bar = bar; b.x = xb_xcc_id(); b.st = st;
    if (opq_tid() == 0) (void)xb_add(&bar[XB_XCNT(b.x)], 1u);
    return b;
}
__device__ __forceinline__ void xcd_barrier_complete(unsigned* bar, unsigned x, unsigned& nloc, unsigned& nx) {
    const unsigned G = gridDim.x * gridDim.y * gridDim.z;
    unsigned sum, cnt, mine, sp = 0u;
    for (;;) {
        sum = 0u; cnt = 0u; mine = 0u;
#pragma unroll
        for (unsigned j = 0; j < 16; ++j) { const unsigned c = xb_ld(&bar[XB_XCNT(j)]); sum += c; cnt += (c > 0u) ? 1u : 0u; mine = (j == x) ? c : mine; }
        if (sum == G) break;
        __builtin_amdgcn_s_sleep(1);
        if ((++sp & 255u) == 0u) { if (xb_ld(&bar[XB_TMO])) break; if (sp > XB_SPIN_CAP) { atomicAdd(&bar[XB_TMO], 1u); break; } }
    }
    nloc = mine > 0u ? mine : 1u; nx = cnt > 0u ? cnt : 1u;
}

__device__ __forceinline__ void xcd_barrier(const XcdBarrier& b) {
    asm volatile("s_waitcnt vmcnt(0)" ::: "memory");
    __syncthreads();
    if (opq_tid() == 0) {
        unsigned* bar = b.bar;
        __builtin_amdgcn_s_waitcnt(0);
        unsigned nloc = b.st[0], nx = b.st[1];
        if (nloc == 0u) { xcd_barrier_complete(bar, b.x, nloc, nx); b.st[0] = nloc; b.st[1] = nx; }
        const unsigned old = xb_add(&bar[XB_XSUB(b.x)], 1u);
        const unsigned gen = old / nloc;
        if (old + 1u == (gen + 1u) * nloc) {
            __builtin_amdgcn_fence(__ATOMIC_RELEASE, "agent");
            asm volatile("s_waitcnt vmcnt(0)" ::: "memory");
            const unsigned og = xb_add(&bar[XB_TOP], 1u);
            const unsigned tg = og / nx;
            if (og + 1u == (tg + 1u) * nx) xb_add(&bar[XB_TOPGEN], 1u);
            else XB_SPIN(xb_ld(&bar[XB_TOPGEN]) == tg, bar);
            __builtin_amdgcn_fence(__ATOMIC_ACQUIRE, "agent");
            xb_add(&bar[XB_XGEN(b.x)], 1u);
            asm volatile("s_waitcnt vmcnt(0)" ::: "memory");
        } else {
            XB_SPIN(xb_ld(&bar[XB_XGEN(b.x)]) == gen, bar);
            __builtin_amdgcn_fence(__ATOMIC_ACQUIRE, "agent");
            asm volatile("s_waitcnt vmcnt(0)" ::: "memory");
        }
    }
    __syncthreads();
}

namespace mk {
DI void phase_convert(const Params& p, unsigned char* lds, const int layer, const int me_ = -1, const int nw_ = 0, const int part = 0) {
  const int half = opq_tid() >> 8, t256 = opq_tid() & 255;
  float* tile = (float*)lds + half * (2 * 64 * 65);
  constexpr int n_in_items = (NU / 64) * (DM / 128), n_out_items = (DM / 64) * (DM / 128);
  const int n_items = part == 0 ? n_in_items : n_out_items;
  const int nw = nw_ > 0 ? nw_ : (int)gridDim.x; const int me = me_ >= 0 ? me_ : (int)blockIdx.x;
  const float* W = nullptr; bf16_t* WT = nullptr; int nsrc = 0, n0 = 0, k0 = 0; bool val = false;
  float4 v[2][4];
#define CONV_ISSUE(it_) do { const int it = (it_); val = it < n_items; if (val) { int is_in; \
      if (part == 0) { n0 = (it % (NU / 64)) * 64; k0 = (it / (NU / 64)) * 128; W = p.w_in + (size_t)layer * DM * NIN; WT = (bf16_t*)(p.ws + WS_WIN); nsrc = NIN; is_in = 1; } \
      else { const int r = it; n0 = (r % 32) * 64; k0 = (r / 32) * 128; W = p.w_out + (size_t)layer * DM * DM; WT = (bf16_t*)(p.ws + WS_WOUT) + (size_t)layer * DM * DM; nsrc = DM; is_in = 0; } \
      const int n = n0 + (t256 & 15) * 4; const int sc = is_in ? ucol_src(n) : n;        \
      _Pragma("unroll") for (int sb = 0; sb < 2; ++sb) _Pragma("unroll") for (int i = 0; i < 4; ++i) { const int kk = 64 * sb + (t256 >> 4) + 16 * i; \
        v[sb][i] = sc >= 0 ? *(const float4*)(W + (size_t)(k0 + kk) * nsrc + sc) : make_float4(0.f, 0.f, 0.f, 0.f); } } } while (0)
  int it0 = me * 2;
  CONV_ISSUE(it0 + half);
  for (; it0 < n_items; it0 += nw * 2) {
    if (val) {
#pragma unroll
      for (int sb = 0; sb < 2; ++sb)
#pragma unroll
        for (int i = 0; i < 4; ++i) { const int kk = (t256 >> 4) + 16 * i; float* tp = tile + sb * (64 * 65) + kk * 65 + (t256 & 15) * 4; tp[0] = v[sb][i].x; tp[1] = v[sb][i].y; tp[2] = v[sb][i].z; tp[3] = v[sb][i].w; }
    }
    __syncthreads();
    const bool cval = val; bf16_t* const cWT = WT; const int cn0 = n0, ck0 = k0;
    CONV_ISSUE(it0 + nw * 2 + half);
    if (cval) {
      const int nn = t256 >> 2, kc = (t256 & 3) * 16;
#pragma unroll
      for (int sb = 0; sb < 2; ++sb) { unsigned wv[8];
#pragma unroll
        for (int j = 0; j < 8; ++j) wv[j] = (unsigned)f2bf(tile[sb * (64 * 65) + (kc + 2 * j) * 65 + nn]) | ((unsigned)f2bf(tile[sb * (64 * 65) + (kc + 2 * j + 1) * 65 + nn]) << 16);
        uint4* dst = (uint4*)(cWT + (size_t)(cn0 + nn) * DM + ck0 + 64 * sb + kc);
        dst[0] = make_uint4(wv[0], wv[1], wv[2], wv[3]); dst[1] = make_uint4(wv[4], wv[5], wv[6], wv[7]); }
    }
    __syncthreads();
  }
#undef CONV_ISSUE
}
DI void phase_mod(const Params& p, unsigned char* lds) {
  const int tid = opq_tid(), lane = tid & 63, w = tid >> 6;
  float* sv = (float*)lds;
  float* red = sv + 5 * DM;
  bool loaded = false;
  for (int u = blockIdx.x; u < 2 * 3 * DM / 48; u += gridDim.x) {
    if (!loaded) { for (int i = tid; i < 5 * DM; i += 512) { const int r = i / DM, k = i % DM; const float v = r < 4 ? p.c[r * DM + k] : p.c_ctx[k]; sv[i] = siluf(v); } loaded = true; __syncthreads(); }
    const int col0 = 48 * u, l = col0 / (3 * DM), n0 = col0 % (3 * DM), q = lane & 15, rgi = w * 4 + (lane >> 4);
    float acc[5][4];
#pragma unroll
    for (int r = 0; r < 5; ++r)
#pragma unroll
      for (int c = 0; c < 4; ++c) acc[r][c] = 0.f;
    if (q < 12) {
      const float* W = p.ada_w + (size_t)l * DM * 3 * DM + n0 + 4 * q + (size_t)rgi * 3 * DM;
#pragma unroll 1
      for (int s0 = 0; s0 < 64; s0 += 8) {
        float4 wv[8];
#pragma unroll
        for (int j = 0; j < 8; ++j) wv[j] = *(const float4*)(W + (size_t)(32 * (s0 + j)) * 3 * DM);
#pragma unroll
        for (int j = 0; j < 8; ++j) { const int k = 32 * (s0 + j) + rgi;
#pragma unroll
          for (int r = 0; r < 5; ++r) { const float sx = sv[r * DM + k]; acc[r][0] += sx * wv[j].x; acc[r][1] += sx * wv[j].y; acc[r][2] += sx * wv[j].z; acc[r][3] += sx * wv[j].w; } }
      }
#pragma unroll
      for (int r = 0; r < 5; ++r)
#pragma unroll
        for (int c = 0; c < 4; ++c) red[(rgi * 5 + r) * 48 + 4 * q + c] = acc[r][c];
    }
    __syncthreads();
    if (tid < 240) { const int r = tid / 48, c = tid % 48; float sm = 0.f;
#pragma unroll
      for (int g = 0; g < 32; ++g) sm += red[(g * 5 + r) * 48 + c];
      ((float*)(p.ws + WS_MOD))[(size_t)l * 5 * 3 * DM + (size_t)r * 3 * DM + n0 + c] = sm + p.ada_b[l * 3 * DM + n0 + c]; }
    __syncthreads();
  }
}
DI void phase_rope(const Params& p) {
  if (blockIdx.x != gridDim.x - 1 || opq_tid() >= 32) return;
  const int f = opq_tid();
  float* ct = (float*)(p.ws + WS_ROPE); float* st = ct + 64 * 32;
  double th = 1.0; for (int i = 0; i < f; ++i) th *= 0.749894209332456;
  double sn = 0, cs = 0, term = 1.0;
  for (int n = 0; n < 24; ++n) { if ((n & 1) == 0) cs += ((n >> 1) & 1) ? -term : term; else sn += ((n >> 1) & 1) ? -term : term; term *= th / (double)(n + 1); }
  double c = 1.0, s = 0.0;
  for (int pos = 0; pos < 64; ++pos) { ct[pos * 32 + f] = (float)c; st[pos * 32 + f] = (float)s; const double c2 = c * cs - s * sn, s2 = s * cs + c * sn; c = c2; s = s2; }
}
DI void phase_rows(const Params& p, const int lpost, const int lpre, unsigned char* lds) {
  const int tid = opq_tid(), lane = tid & 63, wv = tid >> 6;
  const int RPW = (MROWS + (int)gridDim.x - 1) / (int)gridDim.x; const int r_begin = blockIdx.x * RPW, r_end = (r_begin + RPW < MROWS) ? r_begin + RPW : MROWS;
  if (r_begin >= MROWS) return;
  const int b0 = r_begin / TOK;
  float* V = (float*)lds;
  { const float* modp = lpost >= 0 ? (const float*)(p.ws + WS_MOD) + (size_t)lpost * 5 * 3 * DM : nullptr; const float* modq = lpre >= 0 ? (const float*)(p.ws + WS_MOD) + (size_t)lpre * 5 * 3 * DM : nullptr;
    for (int i = tid; i < DM; i += 512) {
      if (lpost >= 0) { V[i] = p.post_w[lpost * DM + i]; V[DM + i] = modp[(size_t)4 * 3 * DM + 2 * DM + i]; V[2 * DM + i] = modp[(size_t)b0 * 3 * DM + 2 * DM + i]; }
      if (lpre >= 0) { V[3 * DM + i] = p.pre_w[lpre * DM + i]; V[4 * DM + i] = modq[(size_t)4 * 3 * DM + DM + i]; V[5 * DM + i] = modq[(size_t)b0 * 3 * DM + DM + i]; V[6 * DM + i] = modq[(size_t)4 * 3 * DM + i]; V[7 * DM + i] = modq[(size_t)b0 * 3 * DM + i]; } } }
  __syncthreads();
  const bool from_in = lpost <= 0;
#define ROW_SRC(R_, src_) do { const int b_ = (R_) / TOK, t_ = (R_) % TOK; if (t_ < CTX) src_ = (from_in ? p.ctx : (const float*)(p.ws + WS_XC)) + (size_t)(b_ * CTX + t_) * DM; \
    else src_ = (from_in ? p.x : p.out) + (size_t)(b_ * SEQ + (t_ - CTX)) * DM; } while (0)
#define ROW_XB(R_) ((const bf16_t*)(p.out + (size_t)(((R_) / TOK) * SEQ + ((R_) % TOK - CTX)) * DM) + DM)
  float4 xn[8]; ushort4 yn[8]; ushort4 xb[8];
  int R = r_begin + wv;
  while (R < r_end && (R % TOK) < CTX && lpre < 0) R += 8;
  if (R < r_end) { const float* src; ROW_SRC(R, src);
    if (from_in || (R % TOK) < CTX) {
#pragma unroll
      for (int i = 0; i < 8; ++i) xn[i] = *(const float4*)(src + i * 256 + lane * 4); }
    else { const bf16_t* sb = ROW_XB(R);
#pragma unroll
      for (int i = 0; i < 8; ++i) xb[i] = *(const ushort4*)(sb + i * 256 + lane * 4); }
    if (lpost >= 0) { const bf16_t* Y = (R % TOK) < CTX ? (const bf16_t*)(p.ws + WS_YC) + (size_t)((R / TOK) * CTX + (R % TOK)) * DM : (const bf16_t*)(p.ws + WS_U) + (size_t)R * DM;
#pragma unroll
      for (int i = 0; i < 8; ++i) yn[i] = *(const ushort4*)(Y + i * 256 + lane * 4); } }
  while (R < r_end) {
    const int b = R / TOK, t = R % TOK; const bool isctx = t < CTX;
    float v[32]; float y[32];
#pragma unroll
    for (int i = 0; i < 8; ++i) { if (from_in || isctx) { v[4 * i] = xn[i].x; v[4 * i + 1] = xn[i].y; v[4 * i + 2] = xn[i].z; v[4 * i + 3] = xn[i].w; }
      else { v[4 * i] = bf2f(xb[i].x); v[4 * i + 1] = bf2f(xb[i].y); v[4 * i + 2] = bf2f(xb[i].z); v[4 * i + 3] = bf2f(xb[i].w); }
      y[4 * i] = bf2f(yn[i].x); y[4 * i + 1] = bf2f(yn[i].y); y[4 * i + 2] = bf2f(yn[i].z); y[4 * i + 3] = bf2f(yn[i].w); }
    int Rn = R + 8; while (Rn < r_end && (Rn % TOK) < CTX && lpre < 0) Rn += 8;
    if (Rn < r_end) { const float* src; ROW_SRC(Rn, src);
      if (from_in || (Rn % TOK) < CTX) {
#pragma unroll
        for (int i = 0; i < 8; ++i) xn[i] = *(const float4*)(src + i * 256 + lane * 4); }
      else { const bf16_t* sb = ROW_XB(Rn);
#pragma unroll
        for (int i = 0; i < 8; ++i) xb[i] = *(const ushort4*)(sb + i * 256 + lane * 4); }
      if (lpost >= 0) { const bf16_t* Y = (Rn % TOK) < CTX ? (const bf16_t*)(p.ws + WS_YC) + (size_t)((Rn / TOK) * CTX + (Rn % TOK)) * DM : (const bf16_t*)(p.ws + WS_U) + (size_t)Rn * DM;
#pragma unroll
        for (int i = 0; i < 8; ++i) yn[i] = *(const ushort4*)(Y + i * 256 + lane * 4); } }
    float* dst = isctx ? (float*)(p.ws + WS_XC) + (size_t)(b * CTX + t) * DM : p.out + (size_t)(b * SEQ + (t - CTX)) * DM;
    const bool inl = (b == b0);
    if (lpost >= 0) {
      float ss = 0.f;
#pragma unroll
      for (int i = 0; i < 32; ++i) ss += y[i] * y[i];
      ss = wave_sum(ss); const float rs = rsqrtf(ss * (1.f / DM) + EPS);
      const float* gv = isctx ? V + DM : V + 2 * DM; const float* gg = (const float*)(p.ws + WS_MOD) + (size_t)lpost * 5 * 3 * DM + (size_t)b * 3 * DM + 2 * DM;
#pragma unroll
      for (int i = 0; i < 8; ++i) { const int c0 = i * 256 + lane * 4; const float4 gq = (isctx || inl) ? *(const float4*)(gv + c0) : *(const float4*)(gg + c0), pq = *(const float4*)(V + c0);
        v[4 * i] += gq.x * y[4 * i] * rs * pq.x; v[4 * i + 1] += gq.y * y[4 * i + 1] * rs * pq.y; v[4 * i + 2] += gq.z * y[4 * i + 2] * rs * pq.z; v[4 * i + 3] += gq.w * y[4 * i + 3] * rs * pq.w;
        if (isctx || lpre < 0) { float4 o; o.x = v[4 * i]; o.y = v[4 * i + 1]; o.z = v[4 * i + 2]; o.w = v[4 * i + 3]; *(float4*)(dst + c0) = o; }
        else { ushort4 o; o.x = f2bf(v[4 * i]); o.y = f2bf(v[4 * i + 1]); o.z = f2bf(v[4 * i + 2]); o.w = f2bf(v[4 * i + 3]); *(ushort4*)((bf16_t*)dst + DM + c0) = o; } }
    }
    if (lpre >= 0) {
      float ss = 0.f;
#pragma unroll
      for (int i = 0; i < 32; ++i) ss += v[i] * v[i];
      ss = wave_sum(ss); const float rs = rsqrtf(ss * (1.f / DM) + EPS);
      bf16_t* hb = (bf16_t*)(p.ws + WS_HB) + (size_t)R * DM;
      const float* scv = isctx ? V + 4 * DM : V + 5 * DM; const float* shv = isctx ? V + 6 * DM : V + 7 * DM; const float* mg = (const float*)(p.ws + WS_MOD) + (size_t)lpre * 5 * 3 * DM + (size_t)b * 3 * DM;
#pragma unroll
      for (int i = 0; i < 8; ++i) { const int c0 = i * 256 + lane * 4; const float4 pq = *(const float4*)(V + 3 * DM + c0);
        const float4 sc = (isctx || inl) ? *(const float4*)(scv + c0) : *(const float4*)(mg + DM + c0), sh = (isctx || inl) ? *(const float4*)(shv + c0) : *(const float4*)(mg + c0);
        ushort4 o; o.x = f2bf(v[4 * i] * rs * pq.x * (1.f + sc.x) + sh.x); o.y = f2bf(v[4 * i + 1] * rs * pq.y * (1.f + sc.y) + sh.y);
        o.z = f2bf(v[4 * i + 2] * rs * pq.z * (1.f + sc.z) + sh.z); o.w = f2bf(v[4 * i + 3] * rs * pq.w * (1.f + sc.w) + sh.w); *(ushort4*)(hb + c0) = o; }
    }
    R = Rn;
  }
#undef ROW_SRC
#undef ROW_XB
  __syncthreads();
}
DI void phase_prep_rows(const Params& p, const int layer) {
  const int lane = opq_tid() & 63, gw = blockIdx.x * 8 + (opq_tid() >> 6), ngw = gridDim.x * 8;
  const float* ct = (const float*)(p.ws + WS_ROPE); const float* st = ct + 64 * 32;
  const int hd = lane >> 4, li = lane & 15, axis = li >> 3, i4 = 4 * (li & 7), d1 = axis * 64 + i4;
  float qw1[4], qw2[4], kw1[4], kw2[4];
#pragma unroll
  for (int j = 0; j < 4; ++j) { qw1[j] = p.qn_w[layer * HD + d1 + j]; qw2[j] = p.qn_w[layer * HD + d1 + 32 + j]; kw1[j] = p.kn_w[layer * HD + d1 + j]; kw2[j] = p.kn_w[layer * HD + d1 + 32 + j]; }
  for (int R = gw; R < MROWS; R += ngw) {
    const int t = R % TOK; const bool isctx = t < CTX; const int pos = t - CTX;
    bf16_t* Ur = (bf16_t*)(p.ws + WS_U) + (size_t)R * NU + hd * HD + d1;
    const bool act1 = hd < 2;
    uint2 u1[4], u2[4];
    if (act1) { u1[1] = *(const uint2*)(Ur + UC_AK); u2[1] = *(const uint2*)(Ur + UC_AK + 32); } else { u1[1] = make_uint2(0u, 0u); u2[1] = make_uint2(0u, 0u); }
    u1[2] = *(const uint2*)(Ur + UC_RQ); u2[2] = *(const uint2*)(Ur + UC_RQ + 32);
    u1[3] = *(const uint2*)(Ur + UC_RK); u2[3] = *(const uint2*)(Ur + UC_RK + 32);
    float cs[4], sn[4];
    if (!isctx) { const int pp = axis == 0 ? (pos >> 6) : (pos & 63); const float4 c4 = *(const float4*)(ct + pp * 32 + i4), s4 = *(const float4*)(st + pp * 32 + i4);
      cs[0] = c4.x; cs[1] = c4.y; cs[2] = c4.z; cs[3] = c4.w; sn[0] = s4.x; sn[1] = s4.y; sn[2] = s4.z; sn[3] = s4.w; }
    else {
#pragma unroll
      for (int j = 0; j < 4; ++j) { cs[j] = 1.f; sn[j] = 0.f; } }
#pragma unroll
    for (int g = 1; g < 4; ++g) {
      float t1[4], t2[4];
      t1[0] = __uint_as_float(u1[g].x << 16); t1[1] = __uint_as_float(u1[g].x & 0xffff0000u); t1[2] = __uint_as_float(u1[g].y << 16); t1[3] = __uint_as_float(u1[g].y & 0xffff0000u);
      t2[0] = __uint_as_float(u2[g].x << 16); t2[1] = __uint_as_float(u2[g].x & 0xffff0000u); t2[2] = __uint_as_float(u2[g].y << 16); t2[3] = __uint_as_float(u2[g].y & 0xffff0000u);
      if (g < 2) { float ss = 0.f;
#pragma unroll
        for (int j = 0; j < 4; ++j) ss += t1[j] * t1[j] + t2[j] * t2[j];
        ss += __shfl_xor(ss, 1); ss += __shfl_xor(ss, 2); ss += __shfl_xor(ss, 4); ss += __shfl_xor(ss, 8);
        const float rs = rsqrtf(ss * (1.f / HD) + EPS);
#pragma unroll
        for (int j = 0; j < 4; ++j) { t1[j] = t1[j] * rs * (g == 0 ? qw1[j] : kw1[j]); t2[j] = t2[j] * rs * (g == 0 ? qw2[j] : kw2[j]); } }
      const float post = g == 3 ? QSCALE : 1.f; float o1[4], o2[4];
#pragma unroll
      for (int j = 0; j < 4; ++j) { o1[j] = (t1[j] * cs[j] - t2[j] * sn[j]) * post; o2[j] = (t2[j] * cs[j] + t1[j] * sn[j]) * post; }
      const int col = g == 0 ? UC_AQ : (g == 1 ? UC_AK : (g == 2 ? UC_RQ : UC_RK));
      if (g != 1 || act1) { *(uint2*)(Ur + col) = make_uint2(scn::cvtpk(o1[0], o1[1]), scn::cvtpk(o1[2], o1[3])); *(uint2*)(Ur + col + 32) = make_uint2(scn::cvtpk(o2[0], o2[1]), scn::cvtpk(o2[2], o2[3])); }
    }
  }
}
DI void signal_done(unsigned* ctr) {
  asm volatile("s_waitcnt vmcnt(0)" ::: "memory"); __syncthreads();
  if (opq_tid() == 0) { __builtin_amdgcn_fence(__ATOMIC_RELEASE, "agent"); __hip_atomic_fetch_add(ctr, 1u, __ATOMIC_RELAXED, __HIP_MEMORY_SCOPE_AGENT); }
}
DI void wait_done(unsigned* ctr, const unsigned want) {
  if (opq_tid() == 0) { unsigned sp = 0; while (__hip_atomic_load(ctr, __ATOMIC_RELAXED, __HIP_MEMORY_SCOPE_AGENT) < want) { __builtin_amdgcn_s_sleep(8); if (++sp > (1u << 22)) break; }
    __builtin_amdgcn_fence(__ATOMIC_ACQUIRE, "agent"); asm volatile("s_waitcnt vmcnt(0)" ::: "memory"); }
  __syncthreads();
}
DI void drain_attention(const Params& p, const int layer, unsigned char* lds, const int max_units) {
  const int nunits = layer == 0 ? 272 : 256;
  unsigned* counter = (unsigned*)(p.ws + WS_CTL) + 16 * layer;
  volatile int* slot = (volatile int*)(lds + LDS_CTL + 64);
  for (int n = 0; n < max_units; ++n) {
    __syncthreads();
    if (opq_tid() == 0) *slot = (int)atomicAdd(counter, 1u);
    __syncthreads();
    const int u = *slot;
    if (u >= nunits) break;
    attn_unit(p, layer, u, (char*)lds);
    if (u >= 256) signal_done((unsigned*)(p.ws + WS_CTL) + 16 * layer + 2);
  }
}
DI void scan_unit(const Params& p, const int layer, const int mix, const int b, const int h, const int blk, unsigned char* lds) {
  if (mix == 0) scn::scan_task<2>(p, layer, b, h, blk, lds); else if (mix == 1) scn::scan_task<0>(p, layer, b, h, blk, lds); else scn::scan_task<1>(p, layer, b, h, blk, lds);
}
template <int layer> DI void phase_mix(const Params& p, unsigned char* lds) {
  constexpr bool need_ctx = layer + 1 < DEPTH;
  unsigned* prepdone = (unsigned*)(p.ws + WS_CTL) + 16 * layer + 1; unsigned* leandone = (unsigned*)(p.ws + WS_CTL) + 16 * layer + 3;
  if (blockIdx.x < 96) { const int bid = blockIdx.x, mix = bid >> 5, b = (bid >> 3) & 3, h = (bid >> 1) & 3, dir = bid & 1;
    if (mix == 0) scn::scan_lean<2>(p, layer, b, h, dir, lds); else if (mix == 1) scn::scan_lean<0>(p, layer, b, h, dir, lds); else scn::scan_lean<1>(p, layer, b, h, dir, lds);
    signal_done(leandone); }
  drain_attention(p, layer, lds, 1 << 30);
  bool leans_in = false;
  volatile int* slot = (volatile int*)(lds + LDS_CTL + 64);
  unsigned* donec = (unsigned*)(p.ws + WS_CTL) + 16 * layer + 2;
  if (need_ctx) { unsigned* counter = (unsigned*)(p.ws + WS_CTL) + 16 * layer + 8;
    for (;;) {
      __syncthreads();
      if (opq_tid() == 0) *slot = (int)atomicAdd(counter, 1u);
      __syncthreads();
      const int u = *slot;
      if (u >= 48) break;
      if (!leans_in) { wait_done(leandone, 96u); leans_in = true; }
      scan_unit(p, layer, u >> 4, (u >> 2) & 3, u & 3, 0, lds);
      signal_done(donec);
    } }
  { unsigned* counter = (unsigned*)(p.ws + WS_CTL) + 16 * layer + 4;
    for (;;) {
      __syncthreads();
      if (opq_tid() == 0) *slot = (int)atomicAdd(counter, 1u);
      __syncthreads();
      const int u = *slot;
      if (u >= 384) break;
      if (!leans_in) { wait_done(leandone, 96u); leans_in = true; }
      const int r = u & 127; scan_unit(p, layer, u >> 7, (r >> 2) & 3, r & 3, 8 - (r >> 4), lds);
    } }
  if (need_ctx) { unsigned* counter = (unsigned*)(p.ws + WS_CTL) + 16 * layer + 6;
    for (;;) {
      __syncthreads();
      if (opq_tid() == 0) *slot = (int)atomicAdd(counter, 1u);
      __syncthreads();
      const int u = *slot;
      if (u >= 32) break;
      wait_done(donec, 48u + 16u);
      const int b = u >> 3, pn = u & 7, pm = 17 * b;
      pg8::Gemm g{(const bf16_t*)(p.ws + WS_HB), (const bf16_t*)(p.ws + WS_WOUT) + (size_t)layer * DM * DM, MROWS, DM, DM}; pg8::OneTile S{pm, pn};
      pg8::EpiBf16 E{(bf16_t*)(p.ws + WS_YC) + ((ptrdiff_t)b * CTX - (ptrdiff_t)pm * 256) * DM, DM, 0};
      pg8::gemm_phase<pg8::EpiBf16, pg8::OneTile, true, true>((PG8_LAS unsigned char*)lds, g, S, E);
    } }
  if (need_ctx) { unsigned* counter = (unsigned*)(p.ws + WS_CTL) + 16 * layer + 10;
    for (;;) {
      __syncthreads();
      if (opq_tid() == 0) *slot = (int)atomicAdd(counter, 1u);
      __syncthreads();
      const int u = *slot;
      if (u >= 264) break;
      phase_convert(p, lds, layer + 1, u, 264);
    } }
}
}

#define GRID_BAR() do { XcdBarrier b_; b_.bar = bar.bar; b_.st = bar.st; asm volatile("" : "+s"(b_.bar)); b_.x = xb_xcc_id(); xcd_barrier(b_); } while (0)
template <int layer> DI void layer_body(const Params& p, unsigned char* lds, const XcdBarrier& bar) {
    { pg8::Gemm g{(const bf16_t*)(p.ws + WS_HB), (const bf16_t*)(p.ws + WS_WIN), MROWS, NU, DM}; pg8::StaticOrder S; S.init(MROWS, NU, (int)gridDim.x, (int)blockIdx.x, 2, (unsigned*)(p.ws + WS_CTL) + 16 * layer + 1);
      pg8::EpiBf16 E{(bf16_t*)(p.ws + WS_U), NU, 1};
      pg8::gemm_phase<pg8::EpiBf16, pg8::StaticOrder, true, true>((PG8_LAS unsigned char*)lds, g, S, E); }
    { unsigned* counter = (unsigned*)(p.ws + WS_CTL) + 16 * layer + 5; volatile int* slot = (volatile int*)(lds + LDS_CTL + 64); bool acq = false, tookl = false;
      for (;;) { __syncthreads(); if (opq_tid() == 0) *slot = (int)atomicAdd(counter, 1u); __syncthreads(); const int u = *slot; if (u >= 48) break;
        if (!acq) { mk::wait_done((unsigned*)(p.ws + WS_CTL) + 16 * layer + 1, 28u); acq = true; }
        if (u < 16) { pdn::prep_unit(p, layer, u >> 2, u & 3, 0, lds); tookl = true; } else { const int v = (u - 16) >> 1; pdn::prep_unit(p, layer, v >> 2, v & 3, 1 + ((u - 16) & 1), lds); } }
      if (!tookl) { unsigned* counter2 = (unsigned*)(p.ws + WS_CTL) + 16 * layer + 14;
        for (;;) { __syncthreads(); if (opq_tid() == 0) *slot = (int)atomicAdd(counter2, 1u); __syncthreads(); const int u = *slot; if (u >= 64) break;
          mk::phase_convert(p, lds, layer, u, 64, 1); } } }
    GRID_BAR();
    mk::phase_prep_rows(p, layer);
    { unsigned* counter = (unsigned*)(p.ws + WS_CTL) + 16 * layer + 12; volatile int* slot = (volatile int*)(lds + LDS_CTL + 64);
    for (;;) { __syncthreads(); if (opq_tid() == 0) *slot = (int)atomicAdd(counter, 1u); __syncthreads(); const int u = *slot; if (u >= 768) break;
      if (u < 256) pdn::prep_unit(p, layer, u >> 6, 4 + (u & 63), 0, lds); else { const int v = (u - 256) >> 1; pdn::prep_unit(p, layer, v >> 6, 4 + (v & 63), 1 + ((u - 256) & 1), lds); }
      } }
    GRID_BAR();
    mk::phase_mix<layer>(p, lds);
    GRID_BAR();
    { pg8::Gemm g{(const bf16_t*)(p.ws + WS_HB), (const bf16_t*)(p.ws + WS_WOUT) + (size_t)layer * DM * DM, MROWS, DM, DM}; pg8::StaticOrder S;
      S.init(NB * SEQ, DM, (int)gridDim.x, (int)blockIdx.x, 1);
      pg8::EpiBf16 E{(bf16_t*)(p.ws + WS_U), DM, 0};
      pg8::gemm_phase<pg8::EpiBf16, pg8::StaticOrder, true, true>((PG8_LAS unsigned char*)lds, g, S, E); }
    GRID_BAR();
    mk::phase_rows(p, layer, layer + 1 < DEPTH ? layer + 1 : -1, lds);
    if (layer + 1 < DEPTH) GRID_BAR();
}

constexpr int MEGA_LDS = LDS_CTL + 256;
__global__ __launch_bounds__(512) void mega_fwd(Params p) {
  extern __shared__ __attribute__((aligned(16))) unsigned char lds_dyn[];
  cg::grid_group grid = cg::this_grid();
  unsigned char* lds = lds_dyn;
  if (blockIdx.x == 0) { for (int i = opq_tid(); i < 64; i += 512) ((unsigned*)(p.ws + WS_CTL))[i] = 0u; for (int i = opq_tid(); i < XCD_BAR_WORDS; i += 512) ((unsigned*)(p.ws + WS_CTL) + 1024)[i] = 0u; }
  if (opq_tid() < 2) ((LAS unsigned*)(lds + LDS_CTL + 128))[opq_tid()] = 0u;
  __syncthreads();
  grid.sync();
  XcdBarrier bar = xcd_barrier_post((unsigned*)(p.ws + WS_CTL) + 1024, (volatile LAS unsigned*)(lds + LDS_CTL + 128));
  mk::phase_mod(p, lds);
  mk::phase_convert(p, lds, 0);
  mk::phase_rope(p);
  GRID_BAR();
  mk::phase_rows(p, -1, 0, lds);
  GRID_BAR();
  layer_body<0>(p, lds, bar);
  layer_body<1>(p, lds, bar);
}

extern "C" void kernel_launch(void* const* d_in, const int* in_sizes, int n_in, void* d_out, int out_size, void* d_ws, size_t ws_size, hipStream_t stream) {
  if (n_in != 19 || ws_size < WS_END) { fprintf(stderr, "kernel_launch: bad args n_in %d ws %zu need %zu\n", n_in, ws_size, (size_t)WS_END); return; }
  static int grid_blocks = 0;
  if (!grid_blocks) {
    int dev = 0, cus = 0, per_cu = 0;
    hipGetDevice(&dev); hipDeviceGetAttribute(&cus, hipDeviceAttributeMultiprocessorCount, dev);
    if (hipFuncSetAttribute((const void*)mega_fwd, hipFuncAttributeMaxDynamicSharedMemorySize, MEGA_LDS) != hipSuccess) fprintf(stderr, "hipFuncSetAttribute failed\n");
    hipOccupancyMaxActiveBlocksPerMultiprocessor(&per_cu, (const void*)mega_fwd, 512, MEGA_LDS);
    if (per_cu < 1) { fprintf(stderr, "occupancy query returned %d\n", per_cu); per_cu = 1; }
    grid_blocks = cus * 1;
    if (grid_blocks < 48) fprintf(stderr, "grid too small\n");
  }
  Params p{};
  const float** pp = (const float**)&p;
  for (int i = 0; i < 19; ++i) pp[i] = (const float*)d_in[i];
  p.out = (float*)d_out; p.ws = (unsigned char*)d_ws;
  void* args[] = {&p};
  hipError_t e = hipLaunchCooperativeKernel((const void*)mega_fwd, dim3(grid_blocks), dim3(512), args, MEGA_LDS, stream);
  if (e != hipSuccess) fprintf(stderr, "cooperative launch failed: %s (grid %d)\n", hipGetErrorString(e), grid_blocks);
}
```
